# Optimizing an MI355X kernel written in HIP

```python
import jax
import jax.numpy as jnp
from jax import lax
import numpy as np

D_MODEL = 1024
BATCH = 1
SEQ = 16384
DEPTH = 4

EPS = 1e-6
NEG_INF = -1e30
RET_HEADS = 4
RET_DK = 128
RET_DV = 128
RET_CHUNK = 128
RET_ROPE_BASE = 10000.0
SG_GROUPS = 4
SG_DIM = 128
SG_CHUNK = 128
DIL_PAIRS = ((128, 1), (512, 4), (2048, 16))
DIL_HEADS = 4
DIL_HD = 128
DIL_BLOCK = 128
N_DIL = 3
RET_KW = RET_HEADS * RET_DK
RET_W = RET_HEADS * RET_DV
SG_W = SG_GROUPS * SG_DIM
DIL_W = DIL_HEADS * DIL_HD
BRANCH_W = 512
N_BRANCH = 3
D_FF = ((8 * D_MODEL + 3 * 256 - 1) // (3 * 256)) * 256
IN_SPLITS = (RET_KW, RET_KW, RET_W, RET_W, SG_W, SG_W,
             N_DIL * DIL_W, N_DIL * DIL_W, N_DIL * DIL_W, N_BRANCH * D_MODEL)
N_IN = 10752

kernel_name = "hybrid_retention_gmlp_dilated_attention_trunk"


def rms_norm(x, g):
    xf = x.astype(jnp.float32)
    y = xf * lax.rsqrt(jnp.mean(xf * xf, axis=-1, keepdims=True) + EPS)
    return (y * g.astype(jnp.float32)).astype(x.dtype)


def rms_normalize(x):
    xf = x.astype(jnp.float32)
    return xf * lax.rsqrt(jnp.mean(xf * xf, axis=-1, keepdims=True) + EPS)


def layer_norm(x, g, b):
    xf = x.astype(jnp.float32)
    mu = jnp.mean(xf, axis=-1, keepdims=True)
    xc = xf - mu
    var = jnp.mean(xc * xc, axis=-1, keepdims=True)
    return (xc * lax.rsqrt(var + EPS) * g.astype(jnp.float32) + b.astype(jnp.float32)).astype(x.dtype)


def split_cols(z):
    idx, acc = [], 0
    for n in IN_SPLITS[:-1]:
        acc += n
        idx.append(acc)
    return jnp.split(z, idx, axis=-1)


def rotary(x, pos):
    half = x.shape[-1] // 2
    inv = 1.0 / (RET_ROPE_BASE ** (jnp.arange(half, dtype=jnp.float32) / half))
    ang = pos.astype(jnp.float32)[:, None] * inv[None, :]
    cos = jnp.cos(ang)[None, :, None, :]
    sin = jnp.sin(ang)[None, :, None, :]
    xf = x.astype(jnp.float32)
    x1, x2 = xf[..., :half], xf[..., half:]
    return jnp.concatenate([x1 * cos - x2 * sin, x1 * sin + x2 * cos], axis=-1)


def retention(q, k, v):
    B, S, H, dk = q.shape
    dv = v.shape[-1]
    C = RET_CHUNK
    nc = S // C
    log_g = jnp.log1p(-(2.0 ** (-5.0 - jnp.arange(H, dtype=jnp.float32))))
    qc = q.reshape(B, nc, C, H, dk)
    kc = k.reshape(B, nc, C, H, dk) * (dk ** -0.5)
    vc = v.astype(jnp.float32).reshape(B, nc, C, H, dv)
    n = jnp.arange(C, dtype=jnp.float32)
    diff = n[:, None] - n[None, :]
    decay_in = jnp.where(diff >= 0, jnp.exp(log_g[:, None, None] * jnp.maximum(diff, 0.0)), 0.0)
    scores = jnp.einsum('bcnhd,bcmhd->bchnm', qc, kc) * decay_in
    inner = jnp.einsum('bchnm,bcmhe->bcnhe', scores, vc)
    zeta = jnp.exp(log_g[:, None] * (C - 1.0 - n)[None, :])
    chunk_kv = jnp.einsum('bcmhd,hm,bcmhe->bchde', kc, zeta, vc)
    g_chunk = jnp.exp(log_g * C)

    def step(R, s):
        return R * g_chunk[None, :, None, None] + s, R

    R0 = jnp.zeros((B, H, dk, dv), jnp.float32)
    _, R_prev = lax.scan(step, R0, jnp.moveaxis(chunk_kv, 1, 0))
    R_prev = jnp.moveaxis(R_prev, 0, 1)
    xi = jnp.exp(log_g[:, None] * (n + 1.0)[None, :])
    cross = jnp.einsum('bcnhd,bchde,hn->bcnhe', qc, R_prev, xi)
    return (inner + cross).reshape(B, S, H, dv)


def spatial_gating(u, v, ln_g, ln_b, w_s, b_s):
    B, S, _ = v.shape
    nc = S // SG_CHUNK
    v = layer_norm(v, ln_g, ln_b)
    vg = v.reshape(B, nc, SG_CHUNK, SG_GROUPS, SG_DIM)
    mask = jnp.tril(jnp.ones((SG_CHUNK, SG_CHUNK), dtype=bool))
    ws = jnp.where(mask[None], w_s, jnp.zeros_like(w_s))
    mixed = jnp.einsum('gnm,bcmgd->bcngd', ws, vg) + b_s.T[None, None, :, :, None]
    return u * mixed.reshape(B, S, SG_W)


def dilated_window_attention(q, k, v, window, dilation):
    B, S, H, hd = q.shape
    d = dilation
    n_back = window // d
    nprev = -(-n_back // DIL_BLOCK)
    span = d * DIL_BLOCK
    Lp = -(-S // span) * span
    L = Lp // d
    nb = L // DIL_BLOCK
    N = B * d

    def to_sub(t):
        t = jnp.pad(t.astype(jnp.float32), ((0, 0), (0, Lp - S), (0, 0), (0, 0)))
        t = t.reshape(B, L, d, H, hd).transpose(0, 2, 1, 3, 4)
        return t.reshape(N, nb, DIL_BLOCK, H, hd)

    qb, kb, vb = to_sub(q), to_sub(k), to_sub(v)

    def band(t):
        tp = jnp.pad(t, ((0, 0), (nprev, 0), (0, 0), (0, 0), (0, 0)))
        return jnp.concatenate([tp[:, j:j + nb] for j in range(nprev + 1)], axis=2)

    kw, vw = band(kb), band(vb)
    KW = (nprev + 1) * DIL_BLOCK
    i = jnp.arange(DIL_BLOCK)[:, None]
    j = jnp.arange(KW)[None, :]
    dist = i + nprev * DIL_BLOCK - j
    blk = jnp.arange(nb)[:, None, None]
    kpos = (blk - nprev) * DIL_BLOCK + j[None]
    valid = (dist >= 0)[None] & (dist <= n_back)[None] & (kpos >= 0)
    s = jnp.einsum('nbqhd,nbkhd->nbhqk', qb, kw) * (hd ** -0.5)
    s = jnp.where(valid[None, :, None], s, NEG_INF)
    m = jnp.max(s, axis=-1, keepdims=True)
    e = jnp.exp(s - m)
    den = jnp.sum(e, axis=-1, keepdims=True)
    lse = jnp.swapaxes((m + jnp.log(den))[..., 0], 2, 3)
    o = jnp.einsum('nbhqk,nbkhd->nbqhd', e, vw) / jnp.swapaxes(den[..., 0], 2, 3)[..., None]

    def from_sub(t):
        rest = t.shape[3:]
        t = t.reshape((B, d, L) + rest)
        t = jnp.moveaxis(t, 1, 2).reshape((B, Lp) + rest)
        return t[:, :S]

    return from_sub(o), from_sub(lse)


def setup_inputs(seed: int = 0) -> dict:
    key = jax.random.key(seed)
    ks = jax.random.split(key, 16)
    f32 = jnp.float32
    nrm = lambda k, shape: jax.random.normal(k, shape, f32)
    x = nrm(ks[0], (BATCH, SEQ, D_MODEL))
    g_mix = 1.0 + 0.02 * nrm(ks[1], (DEPTH, D_MODEL))
    w_in = nrm(ks[2], (DEPTH, D_MODEL, N_IN)) * D_MODEL ** -0.5
    ret_norm_g = 1.0 + 0.02 * nrm(ks[3], (DEPTH, RET_W))
    sg_ln_g = 1.0 + 0.02 * nrm(ks[4], (DEPTH, SG_W))
    sg_ln_b = 0.02 * nrm(ks[5], (DEPTH, SG_W))
    sg_w = nrm(ks[6], (DEPTH, SG_GROUPS, SG_CHUNK, SG_CHUNK)) * SG_CHUNK ** -0.5
    sg_b = 1.0 + 0.02 * nrm(ks[7], (DEPTH, SG_GROUPS, SG_CHUNK))
    dil_q_norm_g = 1.0 + 0.02 * nrm(ks[8], (DEPTH, DIL_HD))
    dil_k_norm_g = 1.0 + 0.02 * nrm(ks[9], (DEPTH, DIL_HD))
    w_branch = nrm(ks[10], (DEPTH, N_BRANCH, BRANCH_W, D_MODEL)) * BRANCH_W ** -0.5
    w_o = nrm(ks[11], (DEPTH, D_MODEL, D_MODEL)) * D_MODEL ** -0.5
    g_ffn = 1.0 + 0.02 * nrm(ks[12], (DEPTH, D_MODEL))
    w_gate_up = nrm(ks[13], (DEPTH, D_MODEL, 2 * D_FF)) * D_MODEL ** -0.5
    w_down = nrm(ks[14], (DEPTH, D_FF, D_MODEL)) * D_FF ** -0.5
    return {"x": x, "g_mix": g_mix, "w_in": w_in, "ret_norm_g": ret_norm_g,
            "sg_ln_g": sg_ln_g, "sg_ln_b": sg_ln_b, "sg_w": sg_w, "sg_b": sg_b,
            "dil_q_norm_g": dil_q_norm_g, "dil_k_norm_g": dil_k_norm_g,
            "w_branch": w_branch, "w_o": w_o, "g_ffn": g_ffn,
            "w_gate_up": w_gate_up, "w_down": w_down}


def reference(x, g_mix, w_in, ret_norm_g, sg_ln_g, sg_ln_b, sg_w, sg_b,
              dil_q_norm_g, dil_k_norm_g, w_branch, w_o, g_ffn, w_gate_up, w_down):
    B, S, D = x.shape
    pos = jnp.arange(S, dtype=jnp.int32)
    for l in range(DEPTH):
        h = rms_norm(x, g_mix[l])
        z = h @ w_in[l]
        qa, ka, va, ga, ub, vb, qc, kc, vc, gates = split_cols(z)
        qa = rotary(qa.reshape(B, S, RET_HEADS, RET_DK), pos)
        ka = rotary(ka.reshape(B, S, RET_HEADS, RET_DK), pos)
        ya = retention(qa, ka, va.reshape(B, S, RET_HEADS, RET_DV))
        ya = rms_normalize(ya) * ret_norm_g[l].reshape(RET_HEADS, RET_DV).astype(jnp.float32)
        ya = (jax.nn.silu(ga.astype(jnp.float32)) * ya.reshape(B, S, RET_W)).astype(x.dtype)
        yb = spatial_gating(jax.nn.gelu(ub), jax.nn.gelu(vb), sg_ln_g[l], sg_ln_b[l], sg_w[l], sg_b[l])
        qc = rms_normalize(qc.reshape(B, S, N_DIL, DIL_HEADS, DIL_HD)) * dil_q_norm_g[l].astype(jnp.float32)
        kc = rms_normalize(kc.reshape(B, S, N_DIL, DIL_HEADS, DIL_HD)) * dil_k_norm_g[l].astype(jnp.float32)
        vc = vc.reshape(B, S, N_DIL, DIL_HEADS, DIL_HD)
        outs, lses = [], []
        for gi, (win, dil) in enumerate(DIL_PAIRS):
            o, lse = dilated_window_attention(qc[:, :, gi], kc[:, :, gi], vc[:, :, gi], win, dil)
            outs.append(o)
            lses.append(lse)
        wts = jax.nn.softmax(jnp.stack(lses, axis=0), axis=0)
        yc = jnp.sum(wts[..., None] * jnp.stack(outs, axis=0), axis=0)
        yc = yc.reshape(B, S, DIL_W).astype(x.dtype)
        gt = jax.nn.sigmoid(gates.reshape(B, S, N_BRANCH, D).astype(jnp.float32)).astype(x.dtype)
        merged = (gt[:, :, 0] * (ya @ w_branch[l, 0])
                  + gt[:, :, 1] * (yb @ w_branch[l, 1])
                  + gt[:, :, 2] * (yc @ w_branch[l, 2]))
        x = x + merged @ w_o[l]
        h = rms_norm(x, g_ffn[l])
        gate, up = jnp.split(h @ w_gate_up[l], 2, axis=-1)
        x = x + (jax.nn.silu(gate) * up) @ w_down[l]
    return x
```

```cpp
#include <hip/hip_runtime.h>
#include <cstdio>
#include <cstdint>

#define LAS __attribute__((address_space(3)))
#define GAS __attribute__((address_space(1)))
typedef unsigned short bf16_t;
typedef short bf16x8 __attribute__((ext_vector_type(8)));
typedef short s16x4 __attribute__((ext_vector_type(4)));
typedef float f32x2 __attribute__((ext_vector_type(2)));
typedef float f32x4 __attribute__((ext_vector_type(4)));
typedef float f32x16 __attribute__((ext_vector_type(16)));
typedef unsigned u32x2 __attribute__((ext_vector_type(2)));
typedef unsigned u32x4 __attribute__((ext_vector_type(4)));

constexpr int S = 16384, D = 1024, DEPTH = 4, NIN = 10752, DFF = 2816, NGU = 2 * DFF;
constexpr float EPS = 1e-6f;
constexpr int NWAVES = 8, NTHREADS = 512;

#ifndef MK_N_LAUNCHES
#define MK_N_LAUNCHES 1
#endif
constexpr int PH_PER_LAYER = 8;
constexpr int N_PHASES = 1 + DEPTH * PH_PER_LAYER;

constexpr size_t MiB = 1u << 20;
constexpr size_t WS_CTL = 0, CTL_ZERO_BYTES = 1 * MiB;
constexpr size_t W_IN_B = (size_t)NIN * D * 2, W_B_B = (size_t)3 * D * 512 * 2, W_O_B = (size_t)D * D * 2, W_GU_B = (size_t)NGU * D * 2, W_D_B = (size_t)D * DFF * 2, W_SG_B = (size_t)4 * 128 * 128 * 2;
constexpr size_t WOFF_IN = 0, WOFF_B = WOFF_IN + W_IN_B, WOFF_O = WOFF_B + W_B_B, WOFF_GU = WOFF_O + W_O_B, WOFF_D = WOFF_GU + W_GU_B, WOFF_SG = WOFF_D + W_D_B, W_LAYER_B = WOFF_SG + W_SG_B;
constexpr size_t WOFF_IN8 = WOFF_IN + (size_t)3072 * D * 2;
constexpr size_t WS_W = 1 * MiB;
constexpr size_t WS_CS = 172 * MiB;
constexpr size_t WS_SSQ = 180 * MiB;
constexpr size_t WS_XB = 182 * MiB;
constexpr size_t WS_SEG = 214 * MiB;
constexpr size_t WS_ACT = 214 * MiB;
constexpr size_t WS_DIL = 310 * MiB;
constexpr size_t DIL_NRM_OFF = (size_t)12 * S * 128;
constexpr size_t WS_RP = 310 * MiB, WS_YA = 326 * MiB, WS_YC = 342 * MiB, WS_MERGED = 358 * MiB;
constexpr int GT_LD = 3072 + 64;
constexpr size_t WS_GT = 454 * MiB;
constexpr size_t WS_KVT = 552 * MiB;
constexpr size_t WS_OG = 584 * MiB;
constexpr size_t WS_LSE = 632 * MiB;
constexpr size_t WS_YB = 633 * MiB;
constexpr size_t WS_XB8 = 649 * MiB;
constexpr size_t WS_END = 665 * MiB;
static_assert(WS_W + DEPTH * W_LAYER_B <= WS_CS, "weights fit");
static_assert(WS_SEG + 6 * (size_t)S * 512 * 2 <= WS_DIL && WS_ACT + (size_t)S * DFF * 2 <= WS_DIL, "seg/act");
static_assert(WS_DIL + 3 * (size_t)12 * S * 128 * 2 <= WS_GT && WS_MERGED + (size_t)S * D * 2 <= WS_GT && WS_MERGED >= WS_DIL + (size_t)12 * S * 128 * 2, "dil");
static_assert(WS_GT + (size_t)S * GT_LD <= WS_KVT && WS_KVT + (size_t)512 * 16384 * 4 <= WS_OG && WS_OG + 3 * (size_t)S * 512 * 2 <= WS_LSE, "map");
constexpr int CW_BAR = 4096;

constexpr int LDS_SCRATCH = 147456;
constexpr int GWMAX_OFF = LDS_SCRATCH - 8192 - 512 - 16;
constexpr int GW_OFF = LDS_SCRATCH - 8192 - 512;
constexpr int RSTD_OFF = LDS_SCRATCH - 8192;
constexpr int MISC_OFF = LDS_SCRATCH;
constexpr int LDS_BYTES = LDS_SCRATCH + 256;

typedef __bf16 bf16x2_t __attribute__((ext_vector_type(2)));
__device__ __forceinline__ unsigned cvt_pk_bf16(float lo, float hi) { const f32x2 v = {lo, hi}; const bf16x2_t b = __builtin_convertvector(v, bf16x2_t); return __builtin_bit_cast(unsigned, b); }
__device__ __forceinline__ float bf_lo(unsigned u) { return __uint_as_float(u << 16); }
__device__ __forceinline__ float bf_hi(unsigned u) { return __uint_as_float(u & 0xffff0000u); }
__device__ __forceinline__ float bf2f(bf16_t b) { return __uint_as_float(((unsigned)b) << 16); }
__device__ __forceinline__ bf16_t f2bf(float f) { return (bf16_t)(cvt_pk_bf16(f, 0.f) & 0xffffu); }
__device__ __forceinline__ float fast_exp(float x) { return __builtin_amdgcn_exp2f(x * 1.4426950408889634f); }
__device__ __forceinline__ float sigmoidf_(float x) { return __builtin_amdgcn_rcpf(1.0f + fast_exp(-x)); }
__device__ __forceinline__ float siluf_(float x) { return x * sigmoidf_(x); }
__device__ __forceinline__ float geluf_(float x) { const float u = 0.7978845608028654f * (x + 0.044715f * x * x * x); return x * sigmoidf_(2.0f * u); }
__device__ __forceinline__ float sum_fq(float s) {
    const unsigned u = __float_as_uint(s); const auto r = __builtin_amdgcn_permlane16_swap(u, u, false, false);
    const float t = __uint_as_float(r[0]) + __uint_as_float(r[1]); const unsigned v = __float_as_uint(t); const auto r2 = __builtin_amdgcn_permlane32_swap(v, v, false, false);
    return __uint_as_float(r2[0]) + __uint_as_float(r2[1]);
}
#define LDS_WAIT() asm volatile("s_waitcnt lgkmcnt(0)" ::: "memory")
#define VM_WAIT() asm volatile("s_waitcnt vmcnt(0)" ::: "memory")

#ifndef BAR_EARLY_INV
#define BAR_EARLY_INV 1
#endif
#ifndef F8_TILES
#define F8_TILES 6
#endif
#ifndef WGM_V
#define WGM_V 2
#endif
typedef int pg8_i32x4 __attribute__((ext_vector_type(4)));
namespace pg8 {
#define PG8_LAS __attribute__((address_space(3)))
constexpr int BM = 256, BK = 64, HALF = 128, HTB = HALF * BK * 2  , STAGE_BYTES = 8 * HTB, NXCD = 8, WGM = WGM_V;

__host__ __device__ __forceinline__ int lds_byte(int r, int c) { const int st = (r >> 4) * 2 + (c >> 5), rr = r & 15, cc = c & 31, ob = rr * 64 + cc * 2; return st * 1024 + (ob ^ (((ob >> 9) & 1) << 5)); }
__host__ __device__ __forceinline__ void stage_rc(int b, int& R, int& C) { const int st = b / 1024, sb = b % 1024, swz = sb ^ (((sb >> 9) & 1) << 5); R = (st >> 1) * 16 + swz / 64; C = (st & 1) * 32 + (swz % 64) / 2; }
__host__ __device__ __forceinline__ int perm32(int rho) { const int n = rho >> 4, i = rho & 15; return 8 * (i >> 2) + 4 * n + (i & 3); }

struct Unit { int pm, pn, pb, hf, pnb; };
struct Gemm { const bf16_t* A0; const bf16_t* A1; const bf16_t* A2; const bf16_t* Bt; size_t bstride; int K;
    __device__ __forceinline__ const char* a_ptr(const Unit& u) const { const bf16_t* a = (u.pb == 0) ? A0 : ((u.pb == 1) ? A1 : A2); return (const char*)(a + ((size_t)u.pm * BM + (u.hf == 2 ? HALF : 0)) * K); }
    __device__ __forceinline__ const char* b_ptr(const Unit& u) const { return (const char*)(Bt + (size_t)u.pb * bstride + (size_t)u.pnb * BM * K); }
};

struct StaticOrder {
    int nM, nN, nwg, G, c, NB, pn0, hv, gap_at, gap_len, dense;
    __device__ void init(int M, int N, int G_, int c_, int NB_ = 1, int pn0_ = 0, int hv_ = 0) { nM = M / BM; nN = N / BM; nwg = nM * nN; G = G_; c = c_; NB = NB_; pn0 = pn0_; hv = hv_; gap_at = 1 << 20; gap_len = 0; dense = 0; }
    __device__ void gap(int at, int len, int dense_) { gap_at = at; gap_len = len; dense = dense_; }
    __device__ bool next(int i, Unit& u) const {
        const int it = i / NB; u.pb = i - it * NB; u.hf = 0;
        long L = (long)it * G + c;
        if (hv) { if (L >= 2L * nwg) return false; u.hf = 1 + (int)(L & 1); L >>= 1; }
        if (L >= nwg) return false;
        int wgid = (int)L; { const int q = nwg / NXCD, r = nwg % NXCD, xcd = wgid % NXCD, off = wgid / NXCD; wgid = (xcd < r ? xcd * (q + 1) : r * (q + 1) + (xcd - r) * q) + off; }
        const int nig = WGM * nN, gid = wgid / nig, fm = gid * WGM, gsz = (nM - fm) < WGM ? (nM - fm) : WGM;
        u.pm = fm + ((wgid % nig) % gsz); { const int pl = (wgid % nig) / gsz; u.pn = pn0 + pl + (pl >= gap_at ? gap_len : 0); u.pnb = dense ? pl : u.pn; } return true;
    }
    __device__ __forceinline__ void a_ready(const Unit&) const {}
    __device__ __forceinline__ void done(const Unit&) const {}
};

struct NoPre { __device__ __forceinline__ void operator()() const {} };
template <class Epi, class Sched, bool ALIGN_EPI = false, bool SP2 = false, bool HF = false, bool F8 = false, class Pre = NoPre>
__device__ __forceinline__ void gemm_phase(PG8_LAS unsigned char* lds, const Gemm g, const Sched& S, const Epi& E, const Pre& pre = Pre()) {
    int tid = threadIdx.x; asm volatile("" : "+v"(tid));
    const int wid = __builtin_amdgcn_readfirstlane(tid >> 6), lane = tid & 63, wr = wid >> 2, wc = wid & 3, fr = lane & 15, fq = lane >> 4;
    const int K = g.K, nt = K / BK;
    unsigned voffA[2], voffB[2];
#pragma unroll
    for (int i = 0; i < 2; ++i) { int R, C; stage_rc(tid * 16 + i * 8192, R, C); const int Rb = Epi::PERM ? ((R & ~31) + perm32(R & 31)) : R;
        voffA[i] = (unsigned)(R * K + C) * 2u; voffB[i] = (unsigned)(Rb * K + C) * 2u; }
    const size_t kstep = (size_t)(BK * 2);
    const size_t hstep = (size_t)HALF * K * 2;
    const unsigned ldsw = (unsigned)wid * 1024u;
    const int aoff = lds_byte(wr * 64 + fr, fq * 8), boff = lds_byte(wc * 32 + fr, fq * 8);
#define PG8_SA(b, h) (((b) * 2 + (h)) * HTB)
#define PG8_SB(b, h) ((4 + (b) * 2 + (h)) * HTB)
#define PG8_STAGE(bufoff, gbase, voff) do { _Pragma("unroll") for (int _i = 0; _i < 2; ++_i) \
        __builtin_amdgcn_global_load_lds((const unsigned*)((const char*)(gbase) + (voff)[_i]), (PG8_LAS unsigned*)(lds + (bufoff) + ldsw + _i * 8192), 16, 0, 0); } while (0)
#define PG8_LDA(dst, b, h) do { _Pragma("unroll") for (int m = 0; m < 4; ++m) _Pragma("unroll") for (int k = 0; k < 2; ++k) dst[m][k] = *(const PG8_LAS bf16x8*)(lds + PG8_SA(b, h) + aoff + m * 2048 + k * 1024); } while (0)
#define PG8_LDB(dst, b, h) do { _Pragma("unroll") for (int n = 0; n < 2; ++n) _Pragma("unroll") for (int k = 0; k < 2; ++k) dst[n][k] = *(const PG8_LAS bf16x8*)(lds + PG8_SB(b, h) + boff + n * 2048 + k * 1024); } while (0)
#define PG8_CAT8(x) __builtin_shufflevector(__builtin_bit_cast(pg8_i32x4, (x)[0]), __builtin_bit_cast(pg8_i32x4, (x)[1]), 0, 1, 2, 3, 4, 5, 6, 7)
#define PG8_MMA(ai, bj, At, Bt) do { __builtin_amdgcn_s_setprio(1); \
        if constexpr (F8) { _Pragma("unroll") for (int m = 0; m < 4; ++m) _Pragma("unroll") for (int n = 0; n < 2; ++n) \
            asm volatile("v_mfma_f32_16x16x128_f8f6f4 %0, %1, %2, %0" : "+v"(acc[ai][bj][m][n]) : "v"(PG8_CAT8(Bt[n])), "v"(PG8_CAT8(At[m]))); } \
        else { _Pragma("unroll") for (int m = 0; m < 4; ++m) _Pragma("unroll") for (int n = 0; n < 2; ++n) _Pragma("unroll") for (int k = 0; k < 2; ++k) \
            acc[ai][bj][m][n] = __builtin_amdgcn_mfma_f32_16x16x32_bf16(Bt[n][k], At[m][k], acc[ai][bj][m][n], 0, 0, 0); } \
        __builtin_amdgcn_s_setprio(0); } while (0)
#define PG8_WAIT_V(n) asm volatile("s_waitcnt vmcnt(" #n ")" ::: "memory")
#define PG8_WAIT_L(n) asm volatile("s_waitcnt lgkmcnt(" #n ")" ::: "memory")
#define PG8_BAR __builtin_amdgcn_s_barrier()
#define PG8_SCHED __builtin_amdgcn_sched_barrier(0)
    Unit cur, nxt; int ui = 0;
    if (!S.next(0, cur)) return;
    f32x4 acc[2][2][4][2];
#pragma unroll
    for (int a = 0; a < 2; ++a)
#pragma unroll
        for (int b = 0; b < 2; ++b)
#pragma unroll
            for (int m = 0; m < 4; ++m)
#pragma unroll
                for (int n = 0; n < 2; ++n) acc[a][b][m][n] = (f32x4){0.f, 0.f, 0.f, 0.f};
    bf16x8 At[4][2], B0[2][2], B1[2][2];
    const char* cA = g.a_ptr(cur); const char* cB = g.b_ptr(cur);
    S.a_ready(cur);
    if constexpr (SP2) {
        PG8_STAGE(PG8_SB(0, 0), cB, voffB); PG8_STAGE(PG8_SB(0, 1), cB + hstep, voffB); PG8_STAGE(PG8_SA(0, 0), cA, voffA); PG8_STAGE(PG8_SA(0, 1), cA + hstep, voffA);
        pre();
        if (wr == 1) PG8_BAR;
        PG8_WAIT_V(2); PG8_BAR;
        PG8_STAGE(PG8_SB(1, 0), cB + kstep, voffB); PG8_STAGE(PG8_SA(1, 0), cA + kstep, voffA); PG8_STAGE(PG8_SB(1, 1), cB + hstep + kstep, voffB);
        PG8_WAIT_V(6); PG8_BAR;
    } else {
        PG8_STAGE(PG8_SB(0, 0), cB, voffB); PG8_STAGE(PG8_SA(0, 0), cA, voffA); PG8_STAGE(PG8_SB(0, 1), cB + hstep, voffB); PG8_STAGE(PG8_SA(0, 1), cA + hstep, voffA);
        pre();
        if (wr == 1) PG8_BAR;
        PG8_WAIT_V(4); PG8_BAR;
        PG8_STAGE(PG8_SB(1, 0), cB + kstep, voffB); PG8_STAGE(PG8_SA(1, 0), cA + kstep, voffA); PG8_STAGE(PG8_SB(1, 1), cB + hstep + kstep, voffB);
        PG8_WAIT_V(6); PG8_BAR;
    }
    for (;;) {
        const bool has_next = S.next(ui + 1, nxt);
        const char* nA = has_next ? g.a_ptr(nxt) : cA; const char* nB = has_next ? g.b_ptr(nxt) : cB;
        constexpr bool half = HF;
#pragma unroll 1
        for (int t = 0; t < nt; t += 2) {
            const bool last = (t == nt - 2);
            const char* a1 = cA + (size_t)(t + 1) * kstep;
            const char* a2 = last ? nA : cA + (size_t)(t + 2) * kstep; const char* b2 = last ? nB : cB + (size_t)(t + 2) * kstep;
            const char* a3 = a2 + kstep; const char* b3 = b2 + kstep;
            if (last && has_next) S.a_ready(nxt);
            if constexpr (SP2) {
            PG8_LDB(B0, 0, 0); PG8_LDB(B1, 0, 1); PG8_SCHED; PG8_LDA(At, 0, 0); PG8_STAGE(PG8_SA(1, 1), a1 + hstep, voffA);
            PG8_WAIT_V(8); PG8_WAIT_L(0); PG8_BAR; PG8_MMA(0, 0, At, B0); PG8_MMA(0, 1, At, B1); PG8_BAR; PG8_SCHED;
            if constexpr (!half) PG8_LDA(At, 0, 1); PG8_STAGE(PG8_SB(0, 0), b2, voffB); PG8_STAGE(PG8_SB(0, 1), b2 + hstep, voffB); PG8_STAGE(PG8_SA(0, 0), a2, voffA);
            PG8_WAIT_V(8); PG8_WAIT_L(0); PG8_BAR; if constexpr (!half) { PG8_MMA(1, 0, At, B0); PG8_MMA(1, 1, At, B1); } PG8_BAR; PG8_SCHED;
            PG8_LDB(B0, 1, 0); PG8_LDB(B1, 1, 1); PG8_SCHED; PG8_LDA(At, 1, 0); PG8_STAGE(PG8_SA(0, 1), a2 + hstep, voffA);
            PG8_WAIT_V(8); PG8_WAIT_L(0); PG8_BAR; PG8_MMA(0, 0, At, B0); PG8_MMA(0, 1, At, B1); PG8_BAR; PG8_SCHED;
            if constexpr (!half) PG8_LDA(At, 1, 1); PG8_STAGE(PG8_SB(1, 0), b3, voffB); PG8_STAGE(PG8_SB(1, 1), b3 + hstep, voffB); PG8_STAGE(PG8_SA(1, 0), a3, voffA);
            PG8_WAIT_V(8); PG8_WAIT_L(0); PG8_BAR; if constexpr (!half) { PG8_MMA(1, 0, At, B0); PG8_MMA(1, 1, At, B1); } PG8_BAR; PG8_SCHED;
            } else {
            PG8_LDB(B0, 0, 0); PG8_SCHED; PG8_LDA(At, 0, 0); PG8_STAGE(PG8_SA(1, 1), a1 + hstep, voffA);
            PG8_WAIT_L(8); PG8_BAR; PG8_WAIT_L(0); PG8_MMA(0, 0, At, B0); PG8_BAR; PG8_SCHED;
            PG8_LDB(B1, 0, 1); PG8_STAGE(PG8_SB(0, 0), b2, voffB);
            PG8_BAR; PG8_WAIT_L(0); PG8_MMA(0, 1, At, B1); PG8_BAR;
            PG8_LDA(At, 0, 1); PG8_STAGE(PG8_SA(0, 0), a2, voffA);
            PG8_BAR; PG8_WAIT_L(0); PG8_MMA(1, 0, At, B0); PG8_BAR; PG8_SCHED;
            PG8_STAGE(PG8_SB(0, 1), b2 + hstep, voffB);
            PG8_WAIT_V(6); PG8_BAR; PG8_MMA(1, 1, At, B1); PG8_BAR;
            PG8_LDB(B0, 1, 0); PG8_SCHED; PG8_LDA(At, 1, 0); PG8_STAGE(PG8_SA(0, 1), a2 + hstep, voffA);
            PG8_WAIT_L(8); PG8_BAR; PG8_WAIT_L(0); PG8_MMA(0, 0, At, B0); PG8_BAR; PG8_SCHED;
            PG8_LDB(B1, 1, 1); PG8_STAGE(PG8_SB(1, 0), b3, voffB);
            PG8_BAR; PG8_WAIT_L(0); PG8_MMA(0, 1, At, B1); PG8_BAR;
            PG8_LDA(At, 1, 1); PG8_STAGE(PG8_SA(1, 0), a3, voffA);
            PG8_BAR; PG8_WAIT_L(0); PG8_MMA(1, 0, At, B0); PG8_BAR; PG8_SCHED;
            PG8_STAGE(PG8_SB(1, 1), b3 + hstep, voffB);
            PG8_WAIT_V(6); PG8_BAR; PG8_MMA(1, 1, At, B1); PG8_BAR;
            }
        }
        if constexpr (ALIGN_EPI) { if (wr == 0) PG8_BAR; }
        if constexpr (F8) asm volatile("s_nop 15\n\ts_nop 15" ::: "memory");
        { int fr_ = fr, fq_ = fq; asm volatile("" : "+v"(fr_), "+v"(fq_));
          E(acc, cur, wr, wc, fr_, fq_);
#ifdef REP_EPI
          if constexpr (Epi::REP2) { asm volatile("" : "+v"(fr_), "+v"(fq_)); E(acc, cur, wr, wc, fr_, fq_); }
#endif
        } S.done(cur);
        if (!has_next) break;
        if (!E.keep(cur)) {
#pragma unroll
        for (int a = 0; a < 2; ++a)
#pragma unroll
            for (int b = 0; b < 2; ++b)
#pragma unroll
                for (int m = 0; m < 4; ++m)
#pragma unroll
                    for (int n = 0; n < 2; ++n) acc[a][b][m][n] = (f32x4){0.f, 0.f, 0.f, 0.f};
        }
        cur = nxt; cA = nA; cB = nB; ++ui;
        if constexpr (ALIGN_EPI) { if (wr == 1) PG8_BAR; }
    }
    PG8_WAIT_V(0);
    if constexpr (!ALIGN_EPI) { if (wr == 0) PG8_BAR; }
    PG8_BAR;
#undef PG8_SA
#undef PG8_SB
#undef PG8_STAGE
#undef PG8_LDA
#undef PG8_LDB
#undef PG8_MMA
#undef PG8_CAT8
#undef PG8_WAIT_V
#undef PG8_WAIT_L
#undef PG8_BAR
#undef PG8_SCHED
}
}

__device__ __forceinline__ void load_rstd(const float* ssq, int row0, int fq, float (&rs)[2][4]) {
#pragma unroll
    for (int ai = 0; ai < 2; ++ai)
#pragma unroll
        for (int m = 0; m < 4; ++m) {
            const f32x4 a = *(const f32x4*)(ssq + (size_t)(row0 + ai * 128 + m * 16) * 16 + fq * 4);
            float s = (a[0] + a[1]) + (a[2] + a[3]);
            s += __shfl_xor(s, 16); s += __shfl_xor(s, 32);
            rs[ai][m] = __builtin_amdgcn_rsqf(s * (1.0f / D) + EPS);
        }
    asm volatile("" : "+v"(rs[0][0]), "+v"(rs[0][1]), "+v"(rs[0][2]), "+v"(rs[0][3]), "+v"(rs[1][0]), "+v"(rs[1][1]), "+v"(rs[1][2]), "+v"(rs[1][3]));
}
__device__ __forceinline__ void load_rstd4(const float* ssq, int row0, int fq, float (&rs)[4]) {
#pragma unroll
    for (int m = 0; m < 4; ++m) {
        const f32x4 a = *(const f32x4*)(ssq + (size_t)(row0 + m * 16) * 16 + fq * 4);
        float s = (a[0] + a[1]) + (a[2] + a[3]);
        s += __shfl_xor(s, 16); s += __shfl_xor(s, 32);
        rs[m] = __builtin_amdgcn_rsqf(s * (1.0f / D) + EPS);
    }
}
__device__ __forceinline__ void lds_rstd4(const LAS float* rl, int row0, float (&rs)[4]) {
#pragma unroll
    for (int m = 0; m < 4; ++m) rs[m] = rl[(row0 + m * 16) & 2047];
}
__device__ __forceinline__ u32x4 pack8(const f32x4 v0, const f32x4 v1) { u32x4 w; w.x = cvt_pk_bf16(v0[0], v0[1]); w.y = cvt_pk_bf16(v0[2], v0[3]); w.z = cvt_pk_bf16(v1[0], v1[1]); w.w = cvt_pk_bf16(v1[2], v1[3]); return w; }

#ifndef NT_STORES
#define NT_STORES 0
#endif
#if NT_STORES
#define ST16(p, v) __builtin_nontemporal_store((v), (u32x4*)(p))
#else
#ifdef DUP_SAME
#define ST16(p, v) do { const u32x4 v_ = (v); *(volatile u32x4*)(p) = v_; *(volatile u32x4*)(p) = v_; } while (0)
#else
#define ST16(p, v) (*(u32x4*)(p) = (v))
#endif
#endif
__device__ __forceinline__ u32x4 dpp_swap1(const u32x4 v) { u32x4 r;
#pragma unroll
    for (int j = 0; j < 4; ++j) r[j] = (unsigned)__builtin_amdgcn_update_dpp(0, (int)v[j], 0xB1  , 0xf, 0xf, true);
    return r; }
__device__ __forceinline__ void store_pair(bf16_t* pe, bf16_t* po, const u32x4 A, const u32x4 B, bool odd) {
    const u32x4 Sx = odd ? A : B, R = dpp_swap1(Sx);
    const u32x4 d1 = odd ? R : A, d2 = odd ? B : R; const int co = odd ? 32 : 0;
    *(u32x4*)(pe + co) = d1; *(u32x4*)(po + co) = d2;
}

__device__ __forceinline__ void store_pair8(unsigned char* pe, unsigned char* po, const u32x2 A, const u32x2 B, bool odd) {
    const u32x2 Sx = odd ? A : B; u32x2 R;
    R.x = (unsigned)__builtin_amdgcn_update_dpp(0, (int)Sx.x, 0xB1, 0xf, 0xf, true); R.y = (unsigned)__builtin_amdgcn_update_dpp(0, (int)Sx.y, 0xB1, 0xf, 0xf, true);
    const u32x2 d1 = odd ? R : A, d2 = odd ? B : R; const int co = odd ? 32 : 0;
    *(u32x2*)(pe + co) = d1; *(u32x2*)(po + co) = d2;
}
__device__ __forceinline__ unsigned fp8x4(const f32x4 v) { int w = 0; w = __builtin_amdgcn_cvt_pk_fp8_f32(v[0], v[1], w, false); w = __builtin_amdgcn_cvt_pk_fp8_f32(v[2], v[3], w, true); return (unsigned)w; }
__device__ __forceinline__ unsigned q8x4(const f32x4 g) { unsigned w = 0; w = __builtin_amdgcn_cvt_pk_u8_f32(g[0] * 255.f, 0, w); w = __builtin_amdgcn_cvt_pk_u8_f32(g[1] * 255.f, 1, w); w = __builtin_amdgcn_cvt_pk_u8_f32(g[2] * 255.f, 2, w); w = __builtin_amdgcn_cvt_pk_u8_f32(g[3] * 255.f, 3, w); return w; }
__device__ __forceinline__ unsigned q8x4_raw(const f32x4 y) { unsigned w = 0; w = __builtin_amdgcn_cvt_pk_u8_f32(y[0], 0, w); w = __builtin_amdgcn_cvt_pk_u8_f32(y[1], 1, w); w = __builtin_amdgcn_cvt_pk_u8_f32(y[2], 2, w); w = __builtin_amdgcn_cvt_pk_u8_f32(y[3], 3, w); return w; }
__device__ __forceinline__ f32x4 dq8x4(unsigned w) { f32x4 g; g[0] = fmaxf((float)(w & 255u), 0.5f); g[1] = fmaxf((float)((w >> 8) & 255u), 0.5f); g[2] = fmaxf((float)((w >> 16) & 255u), 0.5f); g[3] = fmaxf((float)(w >> 24), 0.5f); return g * (1.0f / 255.0f); }

struct EpiIn {
    static constexpr bool PERM = true;
#ifdef REP_EPI
    static constexpr bool REP2 = (REP_EPI & 1) != 0;
#endif
    const LAS float* rl; const float* cs;
    bf16_t* seg; bf16_t* dil; unsigned char* gt;
    const LAS float* gw;
    __device__ __forceinline__ bool keep(const pg8::Unit&) const { return false; }
    template <int FN>
    __device__ __forceinline__ void rows(const f32x4 (&acc)[2][2][4][2], bf16_t* base  , size_t ldc, int row0, int sh, int wc, int fq, int nai) const {
        const bool odd = (row0 & 1) != 0;
#pragma unroll
        for (int ai = 0; ai < 2; ++ai) if (ai < nai) { float rs4[4]; lds_rstd4(rl, row0 + ai * 128, rs4);
#pragma unroll
            for (int m = 0; m < 4; ++m) {
                const int t = row0 + ai * 128 + m * 16, te = t & ~1, to = te + 1;
                const int tre = ((te & ((1 << sh) - 1)) << (14 - sh)) + (te >> sh), tro = ((to & ((1 << sh) - 1)) << (14 - sh)) + (to >> sh);
                const float r = rs4[m];
                u32x4 pk[2];
#pragma unroll
                for (int bj = 0; bj < 2; ++bj) {
                    f32x4 v0 = acc[ai][bj][m][0] * r, v1 = acc[ai][bj][m][1] * r;
                    if (FN <= 1) {
                        const f32x4* csp = (const f32x4*)(cs + ((size_t)t * 64 + (wc & 1) * 32 + bj * 16 + fq * 4) * 2); const f32x4 c01 = csp[0], c23 = csp[1];
                        const float ks = (FN == 1) ? 0.08838834764831845f : 1.0f;
                        f32x4 o0, o1;
                        o0[0] = (v0[0] * c01[0] - v0[1] * c01[1]) * ks; o0[1] = (v0[0] * c01[1] + v0[1] * c01[0]) * ks;
                        o0[2] = (v0[2] * c01[2] - v0[3] * c01[3]) * ks; o0[3] = (v0[2] * c01[3] + v0[3] * c01[2]) * ks;
                        o1[0] = (v1[0] * c23[0] - v1[1] * c23[1]) * ks; o1[1] = (v1[0] * c23[1] + v1[1] * c23[0]) * ks;
                        o1[2] = (v1[2] * c23[2] - v1[3] * c23[3]) * ks; o1[3] = (v1[2] * c23[3] + v1[3] * c23[2]) * ks;
                        v0 = o0; v1 = o1;
                    } else if (FN == 3) {
                        const float nr = r * -1.4426950408889634f; const f32x4 e0 = acc[ai][bj][m][0] * nr, e1 = acc[ai][bj][m][1] * nr;
#pragma unroll
                        for (int j = 0; j < 4; ++j) { v0[j] *= __builtin_amdgcn_rcpf(1.0f + __builtin_amdgcn_exp2f(e0[j])); v1[j] *= __builtin_amdgcn_rcpf(1.0f + __builtin_amdgcn_exp2f(e1[j])); }
                    } else if (FN == 4) {
                        constexpr float C0 = -2.0f * 0.7978845608028654f * 1.4426950408889634f, C1 = C0 * 0.044715f;
#pragma unroll
                        for (int j = 0; j < 4; ++j) {
                            v0[j] *= __builtin_amdgcn_rcpf(1.0f + __builtin_amdgcn_exp2f(v0[j] * fmaf(v0[j] * v0[j], C1, C0)));
                            v1[j] *= __builtin_amdgcn_rcpf(1.0f + __builtin_amdgcn_exp2f(v1[j] * fmaf(v1[j] * v1[j], C1, C0))); }
                    } else if (FN == 5) {
#pragma unroll
                        for (int j = 0; j < 4; ++j) { v0[j] = sigmoidf_(v0[j]); v1[j] = sigmoidf_(v1[j]); }
                    }
                    pk[bj] = pack8(v0, v1);
                }
                store_pair(base + (size_t)tre * ldc, base + (size_t)tro * ldc, pk[0], pk[1], odd);
            } }
    }
    __device__ __forceinline__ void rows_gate(const f32x4 (&acc)[2][2][4][2], unsigned char* base, int row0, int fq, int nai) const {
        const bool odd = (row0 & 1) != 0;
#pragma unroll
        for (int ai = 0; ai < 2; ++ai) if (ai < nai) { float rs4[4]; lds_rstd4(rl, row0 + ai * 128, rs4);
#pragma unroll
            for (int m = 0; m < 4; ++m) {
                const int t = row0 + ai * 128 + m * 16, te = t & ~1; const float nr = rs4[m] * -1.4426950408889634f;
                u32x2 pk[2];
#pragma unroll
                for (int bj = 0; bj < 2; ++bj) { f32x4 v0 = acc[ai][bj][m][0] * nr, v1 = acc[ai][bj][m][1] * nr;
#pragma unroll
                    for (int j = 0; j < 4; ++j) {
                        v0[j] = __builtin_amdgcn_rcpf(fmaf(__builtin_amdgcn_exp2f(v0[j]), 1.0f / 255.0f, 1.0f / 255.0f)); v1[j] = __builtin_amdgcn_rcpf(fmaf(__builtin_amdgcn_exp2f(v1[j]), 1.0f / 255.0f, 1.0f / 255.0f)); }
                    pk[bj].x = q8x4_raw(v0); pk[bj].y = q8x4_raw(v1); }
                store_pair8(base + (size_t)te * GT_LD, base + (size_t)(te + 1) * GT_LD, pk[0], pk[1], odd);
            } }
    }
    template <bool GAIN>
    __device__ __forceinline__ void rows_qk8(const f32x4 (&acc)[2][2][4][2], unsigned char* base  , float* nrm  , const LAS float* gwc  , int row0, int sh, int fq, int nai) const {
        const bool odd = (row0 & 1) != 0;
        f32x4 w[2][2];
#pragma unroll
        for (int bj = 0; bj < 2; ++bj)
#pragma unroll
            for (int n = 0; n < 2; ++n) { w[bj][n] = (f32x4){1.f, 1.f, 1.f, 1.f}; if (GAIN) w[bj][n] = *(const LAS f32x4*)(gwc + bj * 32 + n * 4); }
#pragma unroll
        for (int ai = 0; ai < 2; ++ai) if (ai < nai) { float rs4[4]; lds_rstd4(rl, row0 + ai * 128, rs4); float sv = 0.f;
#pragma unroll
            for (int m = 0; m < 4; ++m) {
                const int t = row0 + ai * 128 + m * 16, te = t & ~1, to = te + 1;
                const int tre = ((te & ((1 << sh) - 1)) << (14 - sh)) + (te >> sh), tro = ((to & ((1 << sh) - 1)) << (14 - sh)) + (to >> sh);
                const float r = rs4[m]; float ss = 0.f;
                u32x2 pk[2];
#pragma unroll
                for (int bj = 0; bj < 2; ++bj) {
                    f32x4 v0 = acc[ai][bj][m][0] * r, v1 = acc[ai][bj][m][1] * r;
                    ss += ((v0[0] * v0[0] + v0[1] * v0[1]) + (v0[2] * v0[2] + v0[3] * v0[3])) + ((v1[0] * v1[0] + v1[1] * v1[1]) + (v1[2] * v1[2] + v1[3] * v1[3]));
                    if (GAIN) { v0 = v0 * w[bj][0]; v1 = v1 * w[bj][1]; }
                    pk[bj].x = fp8x4(v0); pk[bj].y = fp8x4(v1);
                }
                ss = sum_fq(ss); sv = (fq == m) ? ss : sv;
                store_pair8(base + (size_t)tre * 128, base + (size_t)tro * 128, pk[0], pk[1], odd);
            }
            const int t = row0 + ai * 128 + fq * 16, tr = ((t & ((1 << sh) - 1)) << (14 - sh)) + (t >> sh);
            nrm[(size_t)tr * 2] = sv;
        }
    }
    __device__ __forceinline__ void operator()(f32x4 (&acc)[2][2][4][2], const pg8::Unit& u, int wr, int wc, int fr, int fq) const {
        const int row0 = u.pm * 256 + (u.hf == 2 ? 128 : 0) + wr * 64 + fr, pn = u.pn, cw = wc * 64 + fq * 8, nai = u.hf ? 1 : 2;
        if (pn < 12) {
            const int sg = pn >> 1;
            bf16_t* base = seg + (size_t)sg * S * 512 + (pn & 1) * 256 + cw;
            if (sg == 0) rows<0>(acc, base, 512, row0, 0, wc, fq, nai);
            else if (sg == 1) rows<1>(acc, base, 512, row0, 0, wc, fq, nai);
            else if (sg == 2) rows<2>(acc, base, 512, row0, 0, wc, fq, nai);
            else if (sg == 3) rows<3>(acc, base, 512, row0, 0, wc, fq, nai);
            else rows<4>(acc, base, 512, row0, 0, wc, fq, nai);
        } else if (pn < 30) {
            const int q = pn - 12, which = q / 6, r6 = q - which * 6, g = r6 >> 1, hd = (r6 & 1) * 2 + (wc >> 1);
            bf16_t* base = dil + ((size_t)which * 12 + (size_t)g * 4 + hd) * S * 128 + (cw & 127);
            if (which == 2) rows<2>(acc, base, 128, row0, 2 * g, wc, fq, nai);
            else {
                unsigned char* b8 = (unsigned char*)(dil + (size_t)which * 12 * S * 128) + ((size_t)g * 4 + hd) * S * 128 + (cw & 127);
                float* nrm = (float*)((unsigned char*)(dil + (size_t)which * 12 * S * 128) + DIL_NRM_OFF) + ((size_t)g * 4 + hd) * S * 2 + (wc & 1);
                const LAS float* gwc = gw + (cw & 127);
                if (which == 0) rows_qk8<true>(acc, b8, nrm, gwc, row0, 2 * g, fq, nai); else rows_qk8<false>(acc, b8, nrm, gwc, row0, 2 * g, fq, nai);
            }
        } else {
            rows_gate(acc, gt + (size_t)(pn - 30) * 256 + cw, row0, fq, nai);
        }
    }
};

struct EpiMerge {
    static constexpr bool PERM = true;
#ifdef REP_EPI
    static constexpr bool REP2 = false;
#endif
    const unsigned char* gt; bf16_t* out;
    __device__ __forceinline__ bool keep(const pg8::Unit& u) const { return u.pb < 2; }
    static __device__ __forceinline__ f32x4 lv4(unsigned w) { f32x4 g; g[0] = fmaxf((float)(w & 255u), 0.5f); g[1] = fmaxf((float)((w >> 8) & 255u), 0.5f); g[2] = fmaxf((float)((w >> 16) & 255u), 0.5f); g[3] = fmaxf((float)(w >> 24), 0.5f); return g; }
    __device__ __forceinline__ void operator()(f32x4 (&acc)[2][2][4][2], const pg8::Unit& u, int wr, int wc, int fr, int fq) const {
        const int row0 = u.pm * 256 + wr * 64 + fr, col0 = u.pn * 256 + wc * 32 + fq * 8, pb = u.pb;
        if (pb < 2) {
            u32x2 ga[2][4][2], gb[2][4][2];
#pragma unroll
            for (int ai = 0; ai < 2; ++ai)
#pragma unroll
                for (int m = 0; m < 4; ++m)
#pragma unroll
                    for (int bj = 0; bj < 2; ++bj) { const unsigned char* gp = gt + (size_t)(row0 + ai * 128 + m * 16) * GT_LD + pb * 1024 + col0 + bj * 128;
                        ga[ai][m][bj] = *(const u32x2*)gp; gb[ai][m][bj] = *(const u32x2*)(gp + 1024); }
#pragma unroll
            for (int ai = 0; ai < 2; ++ai)
#pragma unroll
                for (int m = 0; m < 4; ++m)
#pragma unroll
                    for (int bj = 0; bj < 2; ++bj) {
                        f32x4 fa = lv4(ga[ai][m][bj].x), fb = lv4(ga[ai][m][bj].y); const f32x4 da = lv4(gb[ai][m][bj].x), db = lv4(gb[ai][m][bj].y);
#pragma unroll
                        for (int j = 0; j < 4; ++j) { fa[j] *= __builtin_amdgcn_rcpf(da[j]); fb[j] *= __builtin_amdgcn_rcpf(db[j]); }
                        acc[ai][bj][m][0] = acc[ai][bj][m][0] * fa; acc[ai][bj][m][1] = acc[ai][bj][m][1] * fb;
                    }
        } else {
            u32x2 ga[2][4][2];
#pragma unroll
            for (int ai = 0; ai < 2; ++ai)
#pragma unroll
                for (int m = 0; m < 4; ++m)
#pragma unroll
                    for (int bj = 0; bj < 2; ++bj) ga[ai][m][bj] = *(const u32x2*)(gt + (size_t)(row0 + ai * 128 + m * 16) * GT_LD + pb * 1024 + col0 + bj * 128);
#pragma unroll
            for (int ai = 0; ai < 2; ++ai)
#pragma unroll
                for (int m = 0; m < 4; ++m)
#pragma unroll
                    for (int bj = 0; bj < 2; ++bj) {
                        const f32x4 fa = lv4(ga[ai][m][bj].x) * (1.0f / 255.0f), fb = lv4(ga[ai][m][bj].y) * (1.0f / 255.0f);
                        *(u32x4*)(out + (size_t)(row0 + ai * 128 + m * 16) * 1024 + col0 + bj * 128) = pack8(acc[ai][bj][m][0] * fa, acc[ai][bj][m][1] * fb);
                    }
        }
    }
};

struct EpiRes {
    static constexpr bool PERM = true;
#ifdef REP_EPI
    static constexpr bool REP2 = false;
#endif
    const float* xin32; float* xout32; bf16_t* xb; float* ssq; unsigned char* xb8;
    __device__ __forceinline__ bool keep(const pg8::Unit&) const { return false; }
    __device__ __forceinline__ void finish(const f32x4 x0, const f32x4 x1, size_t off, float& q) const {
        if (xout32) { *(f32x4*)(xout32 + off) = x0; *(f32x4*)(xout32 + off + 4) = x1; }
        else { *(u32x4*)(xb + off) = pack8(x0, x1); if (xb8) { u32x2 w8; w8.x = fp8x4(x0); w8.y = fp8x4(x1); *(u32x2*)(xb8 + off) = w8; } }
        q += ((x0[0] * x0[0] + x0[1] * x0[1]) + (x0[2] * x0[2] + x0[3] * x0[3])) + ((x1[0] * x1[0] + x1[1] * x1[1]) + (x1[2] * x1[2] + x1[3] * x1[3]));
    }
    __device__ __forceinline__ void operator()(f32x4 (&acc)[2][2][4][2], const pg8::Unit& u, int wr, int wc, int fr, int fq) const {
        const int row0 = u.pm * 256 + wr * 64 + fr, col0 = u.pn * 256 + wc * 32 + fq * 8;
        if (!xin32) {
            u32x4 xw[8][2];
#define RES_LD(g_) do { _Pragma("unroll") for (int bj = 0; bj < 2; ++bj) xw[g_][bj] = *(const u32x4*)(xb + (size_t)(row0 + ((g_) >> 2) * 128 + ((g_) & 3) * 16) * D + col0 + bj * 128); } while (0)
            RES_LD(0); RES_LD(1); RES_LD(2); RES_LD(3); RES_LD(4); RES_LD(5);
#pragma unroll
            for (int g = 0; g < 8; ++g) {
                const int ai = g >> 2, m = g & 3, t = row0 + ai * 128 + m * 16; const size_t off = (size_t)t * D + col0;
                float q = 0.f;
#pragma unroll
                for (int bj = 0; bj < 2; ++bj) {
                    const u32x4 w = xw[g][bj];
                    const f32x4 x0 = (f32x4){bf_lo(w[0]), bf_hi(w[0]), bf_lo(w[1]), bf_hi(w[1])} + acc[ai][bj][m][0], x1 = (f32x4){bf_lo(w[2]), bf_hi(w[2]), bf_lo(w[3]), bf_hi(w[3])} + acc[ai][bj][m][1];
                    finish(x0, x1, off + bj * 128, q);
                }
                q = sum_fq(q);
                if (fq == 0 && !xout32) ssq[(size_t)t * 16 + u.pn * 4 + wc] = q;
                asm volatile("" ::: "memory");
                if (g == 0) RES_LD(6);
                if (g == 1) RES_LD(7);
            }
#undef RES_LD
            return;
        }
#pragma unroll
        for (int ai = 0; ai < 2; ++ai)
#pragma unroll
            for (int m = 0; m < 4; ++m) {
                const int t = row0 + ai * 128 + m * 16; const size_t off = (size_t)t * D + col0;
                float q = 0.f;
#pragma unroll
                for (int bj = 0; bj < 2; ++bj) {
                    const f32x4 x0 = *(const f32x4*)(xin32 + off + bj * 128) + acc[ai][bj][m][0], x1 = *(const f32x4*)(xin32 + off + bj * 128 + 4) + acc[ai][bj][m][1];
                    finish(x0, x1, off + bj * 128, q);
                }
                q = sum_fq(q);
                if (fq == 0 && !xout32) ssq[(size_t)t * 16 + u.pn * 4 + wc] = q;
                if (m & 1) asm volatile("" ::: "memory");
            }
    }
};

struct EpiGU {
    static constexpr bool PERM = true;
#ifdef REP_EPI
    static constexpr bool REP2 = (REP_EPI & 2) != 0;
#endif
    const LAS float* rl; bf16_t* act;
    __device__ __forceinline__ bool keep(const pg8::Unit&) const { return false; }
    __device__ __forceinline__ void operator()(f32x4 (&acc)[2][2][4][2], const pg8::Unit& u, int wr, int wc, int fr, int fq) const {
        const int row0 = u.pm * 256 + (u.hf == 2 ? 128 : 0) + wr * 64 + fr, col0 = u.pn * 128 + wc * 32 + fq * 8, nai = u.hf ? 1 : 2;
#pragma unroll
        for (int ai = 0; ai < 2; ++ai) if (ai < nai) { float rs4[4]; lds_rstd4(rl, row0 + ai * 128, rs4);
#pragma unroll
            for (int m = 0; m < 4; ++m) {
                const int t = row0 + ai * 128 + m * 16; const float r = rs4[m], nr = r * -1.4426950408889634f, r2 = r * r;
                const f32x4 e0 = acc[ai][0][m][0] * nr, e1 = acc[ai][0][m][1] * nr; f32x4 g0 = acc[ai][0][m][0] * acc[ai][1][m][0], g1 = acc[ai][0][m][1] * acc[ai][1][m][1];
#pragma unroll
                for (int j = 0; j < 4; ++j) { g0[j] *= r2 * __builtin_amdgcn_rcpf(1.0f + __builtin_amdgcn_exp2f(e0[j])); g1[j] *= r2 * __builtin_amdgcn_rcpf(1.0f + __builtin_amdgcn_exp2f(e1[j])); }
                *(u32x4*)(act + (size_t)t * DFF + col0) = pack8(g0, g1);
            } }
    }
};

#ifdef PROBE_KLOOP
struct EpiNull {
    static constexpr bool PERM = true;
#ifdef REP_EPI
    static constexpr bool REP2 = false;
#endif
    __device__ __forceinline__ bool keep(const pg8::Unit&) const { return false; }
    __device__ __forceinline__ void operator()(f32x4 (&acc)[2][2][4][2], const pg8::Unit&, int, int, int, int) const {
#pragma unroll
        for (int a = 0; a < 2; ++a)
#pragma unroll
            for (int b = 0; b < 2; ++b)
#pragma unroll
                for (int m = 0; m < 4; ++m)
#pragma unroll
                    for (int n = 0; n < 2; ++n) asm volatile("" :: "v"(acc[a][b][m][n]));
    }
};
#endif

typedef GAS unsigned gu32;
#define RLX_AGENT __ATOMIC_RELAXED, __HIP_MEMORY_SCOPE_AGENT
struct Frame {
    LAS unsigned char* lds;
    int tid, G, bid;
    unsigned char* ws;
};
enum { IN_X = 0, IN_GMIX, IN_WIN, IN_RETG, IN_SGLNG, IN_SGLNB, IN_SGW, IN_SGB, IN_DILQG, IN_DILKG, IN_WBR, IN_WO, IN_GFFN, IN_WGU, IN_WD, IN_OUT };
__device__ __forceinline__ const float* inp(const Frame& F, int i) { int off = MISC_OFF + 64 + 8 * i; asm volatile("" : "+s"(off));
    const unsigned long long v = *(const LAS unsigned long long*)(F.lds + off); return (const float*)(const GAS float*)v; }
__device__ __forceinline__ const float* uni_ptr(const float* p) { const unsigned long long v = (unsigned long long)p; const unsigned lo = __builtin_amdgcn_readfirstlane((unsigned)v), hi = __builtin_amdgcn_readfirstlane((unsigned)(v >> 32)); return (const float*)(const GAS float*)(((unsigned long long)hi << 32) | lo); }
#define PHASE_IDS() int tid = F.tid; asm volatile("" : "+v"(tid)); const int bid = F.bid; (void)bid; const int lane = tid & 63, wave = __builtin_amdgcn_readfirstlane(tid >> 6); (void)lane; (void)wave
#define MFMA16(a, b, c) __builtin_amdgcn_mfma_f32_16x16x32_bf16((a), (b), (c), 0, 0, 0)
#define MFMA32(a, b, c) __builtin_amdgcn_mfma_f32_32x32x16_bf16((a), (b), (c), 0, 0, 0)
constexpr int MP = 272;

__device__ __forceinline__ int prow(int c) { return (c & ~31) + (((c >> 2) & 1) << 4) + (((c >> 3) & 3) << 2) + (c & 3); }
__device__ __forceinline__ float ret_log2_gamma(int h) { return log2f(1.0f - __builtin_amdgcn_exp2f((float)(-5 - h))); }

__device__ __forceinline__ int wave_cols(int n) { const int r = n & 255; return (n & ~255) + 64 * ((r >> 5) & 3) + 32 * (r >> 7) + (r & 31); }
__device__ __forceinline__ int src_col(int map, int n) {
    if (map == 1) {
        n = wave_cols(n);
        if (n < 1024) { const int p = n & 127; return (n & ~127) + (p >> 1) + 64 * (p & 1); }
        return n;
    }
    if (map == 2) { const int pn = n >> 8, j = n & 255; return (j < 128) ? (128 * pn + j) : (DFF + 128 * pn + (j - 128)); }
    return n;
}
struct P0Item { const float* W; bf16_t* WT; const float* ks; int K, N, map, idx; };
constexpr int P0_I_IN = (D / 64) * (NIN / 32), P0_I_B = (512 / 64) * (D / 32), P0_I_O = (D / 64) * (D / 32), P0_I_GU = (D / 64) * (NGU / 32), P0_I_D = (DFF / 64) * (D / 32);
constexpr int P0_I_LAYER = P0_I_IN + 3 * P0_I_B + P0_I_O + P0_I_GU + P0_I_D;
__device__ __forceinline__ P0Item p0_decode(const Frame& F, int it) {
    const int l = it / P0_I_LAYER; int r = it - l * P0_I_LAYER;
    unsigned char* wl = F.ws + WS_W + (size_t)l * W_LAYER_B;
    P0Item a;
    if (r < P0_I_IN) { a.W = inp(F, IN_WIN) + (size_t)l * D * NIN; a.K = D; a.N = NIN; a.WT = (bf16_t*)(wl + WOFF_IN); a.ks = inp(F, IN_GMIX) + l * D; a.map = 1; a.idx = r; return a; } r -= P0_I_IN;
    if (r < 3 * P0_I_B) { const int b = r / P0_I_B; a.W = inp(F, IN_WBR) + ((size_t)l * 3 + b) * 512 * D; a.K = 512; a.N = D; a.WT = (bf16_t*)(wl + WOFF_B) + (size_t)b * D * 512; a.ks = nullptr; a.map = 0; a.idx = r - b * P0_I_B; return a; } r -= 3 * P0_I_B;
    if (r < P0_I_O) { a.W = inp(F, IN_WO) + (size_t)l * D * D; a.K = D; a.N = D; a.WT = (bf16_t*)(wl + WOFF_O); a.ks = nullptr; a.map = 0; a.idx = r; return a; } r -= P0_I_O;
    if (r < P0_I_GU) { a.W = inp(F, IN_WGU) + (size_t)l * D * NGU; a.K = D; a.N = NGU; a.WT = (bf16_t*)(wl + WOFF_GU); a.ks = inp(F, IN_GFFN) + l * D; a.map = 2; a.idx = r; return a; } r -= P0_I_GU;
    a.W = inp(F, IN_WD) + (size_t)l * DFF * D; a.K = DFF; a.N = D; a.WT = (bf16_t*)(wl + WOFF_D); a.ks = nullptr; a.map = 0; a.idx = r; return a;
}
__device__ __forceinline__ void p0_item_load(const P0Item& a, float (&wv)[32], f32x4 (&sc)[2], int lane) {
    const int nblk = a.N / 32, kb = a.idx / nblk, nb = a.idx - kb * nblk, k0 = 64 * kb, n0 = 32 * nb;
    const int sn = src_col(a.map, n0 + (lane & 31));
#pragma unroll
    for (int i = 0; i < 32; ++i) wv[i] = a.W[(size_t)(k0 + 2 * i + (lane >> 5)) * a.N + sn];
    if (a.ks) { sc[0] = *(const f32x4*)(a.ks + k0 + 8 * (lane & 7)); sc[1] = *(const f32x4*)(a.ks + k0 + 8 * (lane & 7) + 4); }
    else { sc[0] = (f32x4){1.f, 1.f, 1.f, 1.f}; sc[1] = sc[0]; }
}
__device__ __forceinline__ void p0_item_store(const P0Item& a, const float (&wv)[32], const f32x4 (&sc)[2], LAS float* scr, int lane) {
    const int nblk = a.N / 32, kb = a.idx / nblk, nb = a.idx - kb * nblk, k0 = 64 * kb, n0 = 32 * nb;
#pragma unroll
    for (int i = 0; i < 32; ++i) scr[(2 * i + (lane >> 5)) * 33 + (lane & 31)] = wv[i];
    LDS_WAIT(); asm volatile("" ::: "memory");
    const int c = lane & 7;
#if F8_TILES == 6
    const int pnt = n0 >> 8; const bool f8 = a.map == 1 && pnt >= 12; const int lt8 = pnt - 12;
#elif F8_TILES == 5
    const int pnt = n0 >> 8; const bool f8 = a.map == 1 && ((pnt >= 12 && pnt < 30) || pnt >= 38); const int lt8 = pnt < 30 ? pnt - 12 : pnt - 20;
#elif F8_TILES == 4
    const int pnt = n0 >> 8; const bool f8 = a.map == 1 && (pnt < 6 || (pnt >= 12 && pnt < 30)); const int lt8 = pnt < 6 ? pnt : pnt - 6;
#else
    const int pnt = n0 >> 8; const bool f8 = a.map == 1 && ((((F8_TILES) & 1) && pnt >= 12 && pnt < 24) || (((F8_TILES) & 2) && pnt >= 30)); const int lt8 = pnt < 24 ? pnt - 12 : pnt - 18;
#endif
    const bool f8b = a.map == 3;
    if (f8 || f8b) {
        const size_t pitch = f8b ? (size_t)a.K * 2 : (size_t)a.K;
        unsigned char* w8 = f8b ? (unsigned char*)a.WT + (size_t)n0 * pitch + k0 + 8 * c
                                : (unsigned char*)a.WT + (WOFF_IN8 - WOFF_IN) + ((size_t)(lt8 * 256 + (n0 & 255))) * pitch + k0 + 8 * c;
#pragma unroll
        for (int j = 0; j < 4; ++j) { const int n = (lane >> 3) + 8 * j; const LAS float* s = scr + (8 * c) * 33 + n;
            u32x2 o; o.x = fp8x4((f32x4){s[0 * 33] * sc[0][0], s[1 * 33] * sc[0][1], s[2 * 33] * sc[0][2], s[3 * 33] * sc[0][3]});
            o.y = fp8x4((f32x4){s[4 * 33] * sc[1][0], s[5 * 33] * sc[1][1], s[6 * 33] * sc[1][2], s[7 * 33] * sc[1][3]});
            *(u32x2*)(w8 + (size_t)n * pitch) = o; }
    } else {
#pragma unroll
    for (int j = 0; j < 4; ++j) { const int n = (lane >> 3) + 8 * j; const LAS float* s = scr + (8 * c) * 33 + n;
        u32x4 o; o.x = cvt_pk_bf16(s[0 * 33] * sc[0][0], s[1 * 33] * sc[0][1]); o.y = cvt_pk_bf16(s[2 * 33] * sc[0][2], s[3 * 33] * sc[0][3]);
        o.z = cvt_pk_bf16(s[4 * 33] * sc[1][0], s[5 * 33] * sc[1][1]); o.w = cvt_pk_bf16(s[6 * 33] * sc[1][2], s[7 * 33] * sc[1][3]);
        *(u32x4*)(a.WT + (size_t)(n0 + n) * a.K + k0 + 8 * c) = o; }
    }
    LDS_WAIT(); asm volatile("" ::: "memory");
}
__device__ __forceinline__ void p0_items(Frame& F, int it0, int it1, int gw, int NGW) {
    PHASE_IDS();
    LAS float* scr = (LAS float*)(F.lds + wave * 16384);
    if (it0 + gw < it1) {
        int it = it0 + gw; P0Item a = p0_decode(F, it), b = a; float wa[32], wb[32]; f32x4 sa[2], sb[2];
        p0_item_load(a, wa, sa, lane);
        for (;;) {
            const int n1 = it + NGW; const bool h1 = n1 < it1;
            if (h1) { b = p0_decode(F, n1); p0_item_load(b, wb, sb, lane); }
            p0_item_store(a, wa, sa, scr, lane);
            if (!h1) break;
            const int n2 = n1 + NGW; const bool h2 = n2 < it1;
            if (h2) { a = p0_decode(F, n2); p0_item_load(a, wa, sa, lane); }
            p0_item_store(b, wb, sb, scr, lane);
            if (!h2) break;
            it = n2;
        }
    }
}
__device__ __forceinline__ void p0_side(Frame& F, int layer, int part, int nwg) {
    const int first = nwg % F.G, nside = F.G - first;
    if (F.bid < first) return;
    const int wave = __builtin_amdgcn_readfirstlane(F.tid >> 6);
    const int it0 = layer * P0_I_LAYER + (part == 0 ? P0_I_IN : P0_I_LAYER - P0_I_D);
    const int it1 = part == 0 ? layer * P0_I_LAYER + P0_I_LAYER - P0_I_D : (layer + 1 < DEPTH ? (layer + 1) * P0_I_LAYER + P0_I_IN : DEPTH * P0_I_LAYER);
    p0_items(F, it0, it1, (F.bid - first) * NWAVES + wave, nside * NWAVES);
}
__device__ __forceinline__ void p0_prologue(Frame& F) {
    PHASE_IDS();
    const int gw = bid * NWAVES + wave, NGW = F.G * NWAVES;
    p0_items(F, 0, P0_I_IN, gw, NGW);
    const int gt = bid * NTHREADS + tid, NGT = F.G * NTHREADS;
    for (int i = gt; i < DEPTH * 4 * 128 * 128; i += NGT) {
        const int l = i >> 16, r = i & 65535, n = (r >> 7) & 127, m = r & 127;
        const float w = (m <= n) ? inp(F, IN_SGW)[i] : 0.f;
        ((bf16_t*)(F.ws + WS_W + (size_t)l * W_LAYER_B + WOFF_SG))[r] = f2bf(w);
    }
    double inv = 1.0;
    { const double rr = 0.86596432336006535;
      const int fi = gt & 63; for (int j = 0; j < fi; ++j) inv *= rr; }
    for (int i = gt; i < S * 64; i += NGT) {
        const int pos = i >> 6;
        const double a = (double)pos * inv;
        const double kq = __builtin_rint(a * 0.63661977236758134);
        double r = __builtin_fma(-kq, 1.5707963267948966, a); r = __builtin_fma(-kq, 6.123233995736766e-17, r);
        const double r2 = r * r;
        const double sn = r * (1.0 + r2 * (-1.0 / 6 + r2 * (1.0 / 120 + r2 * (-1.0 / 5040 + r2 * (1.0 / 362880 + r2 * (-1.0 / 39916800 + r2 * (1.0 / 6227020800.0)))))));
        const double cn = 1.0 + r2 * (-0.5 + r2 * (1.0 / 24 + r2 * (-1.0 / 720 + r2 * (1.0 / 40320 + r2 * (-1.0 / 3628800 + r2 * (1.0 / 479001600.0 + r2 * (-1.0 / 87178291200.0)))))));
        const int q = (int)((long long)kq & 3);
        const double c = (q == 0) ? cn : (q == 1) ? -sn : (q == 2) ? -cn : sn;
        const double s = (q == 0) ? sn : (q == 1) ? cn : (q == 2) ? -sn : -cn;
        ((f32x2*)(F.ws + WS_CS))[i] = (f32x2){(float)c, (float)s};
    }
    float* ssq = (float*)(F.ws + WS_SSQ);
    bf16_t* xb = (bf16_t*)(F.ws + WS_XB);
    const float* xin = inp(F, IN_X);
    for (int m = gw; m < S; m += 2 * NGW) {
        const int mb = (m + NGW < S) ? m + NGW : m;
        const f32x4* xa = (const f32x4*)(xin + (size_t)m * D) + lane; const f32x4* xc = (const f32x4*)(xin + (size_t)mb * D) + lane;
        f32x4 va[4], vc[4];
#pragma unroll
        for (int j = 0; j < 4; ++j) { va[j] = xa[64 * j]; vc[j] = xc[64 * j]; }
#pragma unroll
        for (int half = 0; half < 2; ++half) {
            const int mr = half ? mb : m; if (half && mb == m) break;
            u32x2* o8 = (u32x2*)(xb + (size_t)mr * D) + lane;
            unsigned* q8 = (unsigned*)(F.ws + WS_XB8 + (size_t)mr * D) + lane;
            float s = 0.f;
#pragma unroll
            for (int j = 0; j < 4; ++j) { const f32x4 v = half ? vc[j] : va[j]; s += (v[0] * v[0] + v[1] * v[1]) + (v[2] * v[2] + v[3] * v[3]); u32x2 w; w.x = cvt_pk_bf16(v[0], v[1]); w.y = cvt_pk_bf16(v[2], v[3]); o8[64 * j] = w; q8[64 * j] = fp8x4(v); }
#pragma unroll
            for (int o = 1; o < 64; o <<= 1) s += __shfl_xor(s, o);
            if (lane < 16) ssq[(size_t)mr * 16 + lane] = (lane == 0) ? s : 0.f;
        }
    }
}

__device__ __forceinline__ void ret_kv_units(Frame& F, int u0, int ustep) {
    PHASE_IDS();
    LAS unsigned char* Vt = F.lds; LAS unsigned char* Kt = F.lds + 128 * MP;
    const bf16_t* KR = (const bf16_t*)(F.ws + WS_SEG) + (size_t)1 * S * 512; const bf16_t* VR = (const bf16_t*)(F.ws + WS_SEG) + (size_t)2 * S * 512;
    if (u0 >= 512) return;
    u32x4 vv[4], kk[4];
#define KV_LOAD(u_) do { const size_t b_ = (size_t)((u_) >> 2) * 128 * 512 + ((u_) & 3) * 128; _Pragma("unroll") for (int i = 0; i < 4; ++i) { const int ch = tid + 512 * i, row = ch >> 4, cc = ch & 15; \
        vv[i] = *(const u32x4*)(VR + b_ + (size_t)row * 512 + cc * 8); kk[i] = *(const u32x4*)(KR + b_ + (size_t)row * 512 + cc * 8); } } while (0)
    KV_LOAD(u0);
    for (int u = u0; u < 512; u += ustep) {
        const int c = u >> 2, h = u & 3; const float lg2 = ret_log2_gamma(h);
#pragma unroll
        for (int i = 0; i < 4; ++i) {
            const int ch = tid + 512 * i, row = ch >> 4, cc = ch & 15;
            const float z = __builtin_amdgcn_exp2f((float)(127 - row) * lg2);
#pragma unroll
            for (int j = 0; j < 4; ++j) {
                *(LAS bf16_t*)(Vt + (cc * 8 + 2 * j) * MP + row * 2) = (bf16_t)(vv[i][j] & 0xffffu);
                *(LAS bf16_t*)(Vt + (cc * 8 + 2 * j + 1) * MP + row * 2) = (bf16_t)(vv[i][j] >> 16);
                const unsigned kz = cvt_pk_bf16(bf_lo(kk[i][j]) * z, bf_hi(kk[i][j]) * z);
                *(LAS bf16_t*)(Kt + (cc * 8 + 2 * j) * MP + row * 2) = (bf16_t)(kz & 0xffffu);
                *(LAS bf16_t*)(Kt + (cc * 8 + 2 * j + 1) * MP + row * 2) = (bf16_t)(kz >> 16);
            }
        }
        __syncthreads();
        { const int un = (u + ustep < 512) ? u + ustep : u; KV_LOAD(un); }
        const int fr = lane & 15, fq = lane >> 4;
        bf16x8 a[4];
#pragma unroll
        for (int ks = 0; ks < 4; ++ks) a[ks] = *(const LAS bf16x8*)(Vt + (wave * 16 + fr) * MP + ks * 64 + fq * 16);
        bf16_t* kvt = (bf16_t*)(F.ws + WS_KVT) + ((size_t)(c * 4 + h) * 128) * 128;
#pragma unroll
        for (int ct = 0; ct < 8; ++ct) {
            f32x4 acc = {0.f, 0.f, 0.f, 0.f};
#pragma unroll
            for (int ks = 0; ks < 4; ++ks) { const bf16x8 b = *(const LAS bf16x8*)(Kt + (ct * 16 + fr) * MP + ks * 64 + fq * 16); acc = MFMA16(b, a[ks], acc); }
            { u32x2 w; w.x = cvt_pk_bf16(acc[0], acc[1]); w.y = cvt_pk_bf16(acc[2], acc[3]); *(u32x2*)(kvt + (size_t)(wave * 16 + fr) * 128 + ct * 16 + fq * 4) = w; }
        }
        __syncthreads();
    }
#undef KV_LOAD
}

__device__ __forceinline__ void ret_scan(Frame& F) {
    PHASE_IDS();
    for (int p0 = bid * 128 + tid; p0 < 32768; p0 += F.G * 128) {
        const int h = p0 >> 13, idx = p0 & 8191;
        const float gc = __builtin_amdgcn_exp2f(128.0f * ret_log2_gamma(h));
        const unsigned* kv = (const unsigned*)(F.ws + WS_KVT) + (size_t)h * 8192 + idx;
        unsigned* rp = (unsigned*)(F.ws + WS_RP) + (size_t)h * 8192 + idx;
        float R0 = 0.f, R1 = 0.f;
        for (int c0 = 0; c0 < 128; c0 += 64) {
            unsigned v[64];
#pragma unroll
            for (int j = 0; j < 64; ++j) v[j] = kv[(size_t)(c0 + j) * 32768];
#pragma unroll
            for (int j = 0; j < 64; ++j) { rp[(size_t)(c0 + j) * 32768] = cvt_pk_bf16(R0, R1); R0 = R0 * gc + bf_lo(v[j]); R1 = R1 * gc + bf_hi(v[j]); }
        }
    }
}

struct RoRegs { u32x4 kk[4], vv[4], rv[4]; bf16x8 aq[4]; };
__device__ __forceinline__ void ro_load(Frame& F, int u, RoRegs& R) {
    PHASE_IDS(); const int fr = lane & 15, fq = lane >> 4;
    const bf16_t* SEG = (const bf16_t*)(F.ws + WS_SEG);
    const bf16_t* QR = SEG, *KR = SEG + (size_t)1 * S * 512, *VR = SEG + (size_t)2 * S * 512;
    const size_t b = (size_t)(u >> 2) * 128 * 512 + (u & 3) * 128; const bf16_t* RP = (const bf16_t*)(F.ws + WS_RP) + (size_t)u * 16384;
#pragma unroll
    for (int i = 0; i < 4; ++i) { const int ch = tid + 512 * i, row = ch >> 4, cc = ch & 15;
        R.kk[i] = *(const u32x4*)(KR + b + (size_t)row * 512 + cc * 8); R.vv[i] = *(const u32x4*)(VR + b + (size_t)row * 512 + cc * 8); R.rv[i] = *(const u32x4*)(RP + (size_t)row * 128 + cc * 8); }
#pragma unroll
    for (int ks = 0; ks < 4; ++ks) R.aq[ks] = *(const bf16x8*)(QR + b + (size_t)(wave * 16 + fr) * 512 + ks * 32 + fq * 8);
}
__device__ __forceinline__ void ro_unit(Frame& F, int layer, int u, const RoRegs& R, int un, RoRegs* nxt) {
    PHASE_IDS(); const int fr = lane & 15, fq = lane >> 4;
    LAS unsigned char* Kl = F.lds; LAS unsigned char* Vt = F.lds + 128 * MP; LAS unsigned char* Rl = F.lds + 2 * 128 * MP; LAS unsigned char* Sl = F.lds + 3 * 128 * MP;
    const bf16_t* GR = (const bf16_t*)(F.ws + WS_SEG) + (size_t)3 * S * 512;
    bf16_t* YA = (bf16_t*)(F.ws + WS_YA);
    const int c = u >> 2, h = u & 3, t0 = c * 128; const float lg2 = ret_log2_gamma(h);
#pragma unroll
    for (int i = 0; i < 4; ++i) {
        const int ch = tid + 512 * i, row = ch >> 4, cc = ch & 15;
        *(LAS u32x4*)(Kl + row * MP + cc * 16) = R.kk[i];
        *(LAS u32x4*)(Rl + prow(row) * MP + cc * 16) = R.rv[i];
#pragma unroll
        for (int j = 0; j < 4; ++j) {
            *(LAS bf16_t*)(Vt + prow(cc * 8 + 2 * j) * MP + row * 2) = (bf16_t)(R.vv[i][j] & 0xffffu);
            *(LAS bf16_t*)(Vt + prow(cc * 8 + 2 * j + 1) * MP + row * 2) = (bf16_t)(R.vv[i][j] >> 16);
        }
    }
    const float* rg = inp(F, IN_RETG) + layer * 512 + h * 128;
    const size_t rowoff = (size_t)(t0 + wave * 16 + fr) * 512 + h * 128;
    u32x4 grv[4]; f32x4 g0v[4], g1v[4];
#pragma unroll
    for (int j = 0; j < 4; ++j) { const int e0 = 32 * j + 8 * fq; grv[j] = *(const u32x4*)(GR + rowoff + e0); g0v[j] = *(const f32x4*)(rg + e0); g1v[j] = *(const f32x4*)(rg + e0 + 4); }
    __syncthreads();
    if (nxt) ro_load(F, un, *nxt);
#pragma unroll
    for (int ct = 0; ct < 8; ++ct) {
        f32x4 acc = {0.f, 0.f, 0.f, 0.f};
#pragma unroll
        for (int ks = 0; ks < 4; ++ks) { const bf16x8 b = *(const LAS bf16x8*)(Kl + (ct * 16 + fr) * MP + ks * 64 + fq * 16); acc = MFMA16(R.aq[ks], b, acc); }
#pragma unroll
        for (int r = 0; r < 4; ++r) {
            const int n = wave * 16 + fq * 4 + r, mm = ct * 16 + fr;
            const float v = (n >= mm) ? acc[r] * __builtin_amdgcn_exp2f((float)(n - mm) * lg2) : 0.f;
            *(LAS bf16_t*)(Sl + n * MP + mm * 2) = f2bf(v);
        }
    }
    __syncthreads();
    bf16x8 as[4];
#pragma unroll
    for (int ks = 0; ks < 4; ++ks) as[ks] = *(const LAS bf16x8*)(Sl + (wave * 16 + fr) * MP + ks * 64 + fq * 16);
    const float xi = __builtin_amdgcn_exp2f((float)(wave * 16 + fr + 1) * lg2);
    f32x4 y[8]; float ss = 0.f;
#pragma unroll
    for (int et = 0; et < 8; ++et) {
        f32x4 o = {0.f, 0.f, 0.f, 0.f}, cr = {0.f, 0.f, 0.f, 0.f};
#pragma unroll
        for (int ks = 0; ks < 4; ++ks) {
            const bf16x8 bv = *(const LAS bf16x8*)(Vt + (et * 16 + fr) * MP + ks * 64 + fq * 16); o = MFMA16(bv, as[ks], o);
            const bf16x8 br = *(const LAS bf16x8*)(Rl + (et * 16 + fr) * MP + ks * 64 + fq * 16); cr = MFMA16(br, R.aq[ks], cr);
        }
        y[et] = o + cr * xi;
        ss += (y[et][0] * y[et][0] + y[et][1] * y[et][1]) + (y[et][2] * y[et][2] + y[et][3] * y[et][3]);
    }
    ss = sum_fq(ss);
    const float rstd = __builtin_amdgcn_rsqf(ss * (1.0f / 128.0f) + EPS);
#pragma unroll
    for (int j = 0; j < 4; ++j) {
        const int e0 = 32 * j + 8 * fq;
        const u32x4 gr = grv[j]; const f32x4 g0 = g0v[j], g1 = g1v[j];
        f32x4 a = y[2 * j] * rstd * g0, b = y[2 * j + 1] * rstd * g1;
        a[0] *= bf_lo(gr[0]); a[1] *= bf_hi(gr[0]); a[2] *= bf_lo(gr[1]); a[3] *= bf_hi(gr[1]);
        b[0] *= bf_lo(gr[2]); b[1] *= bf_hi(gr[2]); b[2] *= bf_lo(gr[3]); b[3] *= bf_hi(gr[3]);
        u32x4 w; w.x = cvt_pk_bf16(a[0], a[1]); w.y = cvt_pk_bf16(a[2], a[3]); w.z = cvt_pk_bf16(b[0], b[1]); w.w = cvt_pk_bf16(b[2], b[3]);
        *(u32x4*)(YA + rowoff + e0) = w;
    }
    __syncthreads();
}
__device__ __forceinline__ void ret_out_units(Frame& F, int layer, int u0, int ustep) {
    for (int u = u0; u < 512; u += 2 * ustep) {
        RoRegs A, B; const int ub = u + ustep;
        ro_load(F, u, A);
        if (ub < 512) { ro_unit(F, layer, u, A, ub, &B); ro_unit(F, layer, ub, B, 0, nullptr); }
        else ro_unit(F, layer, u, A, 0, nullptr);
    }
}

__device__ __forceinline__ void sg_chunk(Frame& F, int layer, int c) {
    PHASE_IDS(); const int fr = lane & 15, fq = lane >> 4;
    LAS unsigned char* Vt = F.lds;
    const bf16_t* UB = (const bf16_t*)(F.ws + WS_SEG) + (size_t)4 * S * 512; const bf16_t* VB = (const bf16_t*)(F.ws + WS_SEG) + (size_t)5 * S * 512;
    bf16_t* YB = (bf16_t*)(F.ws + WS_YB);
    const int t0 = c * 128;
    const int row = wave * 16 + (lane >> 2), q4 = lane & 3;
    float mean, rstd;
    {
        const u32x4* vp = (const u32x4*)(VB + (size_t)(t0 + row) * 512 + q4 * 128);
        u32x4 raw[16]; float s = 0.f;
#pragma unroll
        for (int i = 0; i < 16; ++i) { raw[i] = vp[i];
#pragma unroll
            for (int j = 0; j < 4; ++j) s += bf_lo(raw[i][j]) + bf_hi(raw[i][j]); }
        s += __shfl_xor(s, 1); s += __shfl_xor(s, 2);
        mean = s * (1.0f / 512.0f); float q = 0.f;
#pragma unroll
        for (int i = 0; i < 16; ++i)
#pragma unroll
            for (int j = 0; j < 4; ++j) { const float a = bf_lo(raw[i][j]) - mean, b = bf_hi(raw[i][j]) - mean; q += a * a + b * b; }
        q += __shfl_xor(q, 1); q += __shfl_xor(q, 2);
        rstd = __builtin_amdgcn_rsqf(q * (1.0f / 512.0f) + EPS);
    }
    u32x4 rawA[4], rawB[4], ubA[4], ubB[4]; bf16x8 wA[4], wB[4];
#define SG_LOAD(g_, RAW, WF, UBV) do { \
        const u32x4* gp_ = (const u32x4*)(VB + (size_t)(t0 + row) * 512 + (g_) * 128 + q4 * 32); \
        const bf16_t* W_ = (const bf16_t*)(F.ws + WS_W + (size_t)layer * W_LAYER_B + WOFF_SG) + (size_t)(g_) * 16384; \
        _Pragma("unroll") for (int i = 0; i < 4; ++i) RAW[i] = gp_[i]; \
        _Pragma("unroll") for (int ks = 0; ks < 4; ++ks) WF[ks] = *(const bf16x8*)(W_ + (size_t)(wave * 16 + fr) * 128 + ks * 32 + fq * 8); \
        _Pragma("unroll") for (int j = 0; j < 4; ++j) UBV[j] = *(const u32x4*)(UB + (size_t)(t0 + wave * 16 + fr) * 512 + (g_) * 128 + 32 * j + 8 * fq); } while (0)
#define SG_GROUP(g_, RAW, WF, UBV, NEXT) do { \
        {     \
            const float* lg = inp(F, IN_SGLNG) + layer * 512 + (g_) * 128 + q4 * 32; const float* lb = inp(F, IN_SGLNB) + layer * 512 + (g_) * 128 + q4 * 32; \
            _Pragma("unroll") for (int i = 0; i < 4; ++i) { const u32x4 w = RAW[i]; \
                _Pragma("unroll") for (int j = 0; j < 4; ++j) { \
                    const int ch = i * 8 + 2 * j; \
                    const float a_ = (bf_lo(w[j]) - mean) * rstd * lg[ch] + lb[ch], b_ = (bf_hi(w[j]) - mean) * rstd * lg[ch + 1] + lb[ch + 1]; \
                    const unsigned pk = cvt_pk_bf16(a_, b_); \
                    *(LAS bf16_t*)(Vt + prow(q4 * 32 + ch) * MP + row * 2) = (bf16_t)(pk & 0xffffu); \
                    *(LAS bf16_t*)(Vt + prow(q4 * 32 + ch + 1) * MP + row * 2) = (bf16_t)(pk >> 16); \
                } } \
        } \
        const float bsn = inp(F, IN_SGB)[(layer * 4 + (g_)) * 128 + wave * 16 + fr]; \
        const size_t rowoff = (size_t)(t0 + wave * 16 + fr) * 512 + (g_) * 128; \
        __syncthreads(); \
        NEXT; \
        _Pragma("unroll") for (int j = 0; j < 4; ++j) {                        \
            f32x4 acc0 = {0.f, 0.f, 0.f, 0.f}, acc1 = {0.f, 0.f, 0.f, 0.f}; \
            _Pragma("unroll") for (int ks = 0; ks < 4; ++ks) { \
                const bf16x8 b0 = *(const LAS bf16x8*)(Vt + ((2 * j) * 16 + fr) * MP + ks * 64 + fq * 16); acc0 = MFMA16(b0, WF[ks], acc0); \
                const bf16x8 b1 = *(const LAS bf16x8*)(Vt + ((2 * j + 1) * 16 + fr) * MP + ks * 64 + fq * 16); acc1 = MFMA16(b1, WF[ks], acc1); \
            } \
            const int c0 = 32 * j + 8 * fq; \
            const u32x4 ub = UBV[j]; \
            u32x4 w; \
            w.x = cvt_pk_bf16(bf_lo(ub[0]) * (acc0[0] + bsn), bf_hi(ub[0]) * (acc0[1] + bsn)); w.y = cvt_pk_bf16(bf_lo(ub[1]) * (acc0[2] + bsn), bf_hi(ub[1]) * (acc0[3] + bsn)); \
            w.z = cvt_pk_bf16(bf_lo(ub[2]) * (acc1[0] + bsn), bf_hi(ub[2]) * (acc1[1] + bsn)); w.w = cvt_pk_bf16(bf_lo(ub[3]) * (acc1[2] + bsn), bf_hi(ub[3]) * (acc1[3] + bsn)); \
            *(u32x4*)(YB + rowoff + c0) = w; \
        } \
        __syncthreads(); } while (0)
    SG_LOAD(0, rawA, wA, ubA);
    SG_GROUP(0, rawA, wA, ubA, SG_LOAD(1, rawB, wB, ubB));
    SG_GROUP(1, rawB, wB, ubB, SG_LOAD(2, rawA, wA, ubA));
    SG_GROUP(2, rawA, wA, ubA, SG_LOAD(3, rawB, wB, ubB));
    SG_GROUP(3, rawB, wB, ubB, (void)0);
#undef SG_GROUP
#undef SG_LOAD
}

typedef int at_i32x4 __attribute__((ext_vector_type(4))); typedef int at_i32x8 __attribute__((ext_vector_type(8)));
#define MFMA32F8(a, b, c) __builtin_amdgcn_mfma_f32_32x32x16_fp8_fp8((a), (b), (c), 0, 0, 0)
#define KSWZ8(row, colB) ((row) * 128 + ((colB) ^ (((row) & 7) << 4)))
#define KSWZ(row, colB) ((row) * 256 + ((colB) ^ (((row) & 7) << 4)))
__device__ __forceinline__ int v_st(int k, int c) { const int kk = (k & ~0xC) | ((k & 4) << 1) | ((k & 8) >> 1); return ((kk >> 3) * 4 + (c >> 5)) * 512 + ((kk & 7) * 32 + (c & 31)) * 2; }
__device__ __forceinline__ int v_rd_base(int lane) { return ((lane & 3) << 3) | (((lane >> 2) & 3) << 6) | (((lane >> 4) & 1) << 5) | (((lane >> 5) & 1) << 8); }
constexpr int v_rd_off(int d0, int ks, int half) { return d0 * 512 + ks * 4096 + half * 2048; }
__device__ __forceinline__ int crow(int r, int hi) { return (r & 3) + 8 * (r >> 2) + 4 * hi; }
constexpr float AT_SCALE = 0.08838834764831845f, AT_THR = 8.f;
constexpr int AT_W = 129;
typedef __bf16 bf16x2v __attribute__((ext_vector_type(2)));
__device__ __forceinline__ float dot2sq(unsigned u, float c) { const bf16x2v v = __builtin_bit_cast(bf16x2v, u); return __builtin_amdgcn_fdot2_f32_bf16(v, v, c, false); }

__device__ __forceinline__ void at_pv32(f32x16* o, int vb0, bf16x8 pa0, bf16x8 pa1) {
#define TRRD(dst, off) asm volatile("ds_read_b64_tr_b16 %0, %1 offset:%2" : "=&v"(dst) : "v"(vb0), "i"(off) : "memory")
#define PV_D0(d0) do { s16x4 l0, l1, h0, h1; constexpr int b_ = v_rd_off(d0, 0, 0); \
        TRRD(l0, b_); TRRD(h0, b_ + 2048); TRRD(l1, b_ + 4096); TRRD(h1, b_ + 6144); \
        asm volatile("s_waitcnt lgkmcnt(0)" ::: "memory"); __builtin_amdgcn_sched_barrier(0); \
        o[d0] = MFMA32(pa0, ((bf16x8){l0[0], l0[1], l0[2], l0[3], h0[0], h0[1], h0[2], h0[3]}), o[d0]); \
        o[d0] = MFMA32(pa1, ((bf16x8){l1[0], l1[1], l1[2], l1[3], h1[0], h1[1], h1[2], h1[3]}), o[d0]); } while (0)
    PV_D0(0); PV_D0(1); PV_D0(2); PV_D0(3);
#undef PV_D0
#undef TRRD
}

__device__ __forceinline__ void rstd_fill(Frame& F, const float* ssq, const float* gq, const float* gk) {
    PHASE_IDS();
    if (gq && tid < 128) ((LAS float*)(F.lds + GW_OFF))[tid] = gq[tid] * gk[tid];
    if (gq && tid < 64) {
        float m = fmaxf(fabsf(gq[tid] * gk[tid]), fabsf(gq[tid + 64] * gk[tid + 64]));
#pragma unroll
        for (int o = 1; o < 64; o <<= 1) m = fmaxf(m, __shfl_xor(m, o));
        if (tid == 0) *(LAS float*)(F.lds + GWMAX_OFF) = m;
    }
    const int base = (bid & 7) * 2048;
    LAS float* rl = (LAS float*)(F.lds + RSTD_OFF);
    f32x4 a[4][4];
#pragma unroll
    for (int k = 0; k < 4; ++k)
#pragma unroll
        for (int j = 0; j < 4; ++j) a[k][j] = *(const f32x4*)(ssq + (size_t)(base + tid + 512 * k) * 16 + 4 * j);
#pragma unroll
    for (int k = 0; k < 4; ++k) { const f32x4 s4 = (a[k][0] + a[k][1]) + (a[k][2] + a[k][3]); const float s = (s4[0] + s4[1]) + (s4[2] + s4[3]);
        rl[tid + 512 * k] = __builtin_amdgcn_rsqf(s * (1.0f / D) + EPS); }
    __syncthreads();
}

struct RstdHook { Frame& F; const float* ssq; const float* gq; const float* gk; __device__ __forceinline__ void operator()() const { rstd_fill(F, ssq, gq, gk); } };

__device__ __forceinline__ void attn_unit(Frame& F, int layer, int g, int h, int b) {
    PHASE_IDS(); const int wid = wave, r32 = lane & 31, hi = lane >> 5;
    LAS unsigned char* V_lds = F.lds + wid * 16384; LAS unsigned char* K_lds = V_lds + 8192;
    LAS float* rk_l = (LAS float*)(F.lds + 131072 + wid * 512); LAS float* al_l = rk_l + 32; LAS float* li_l = rk_l + 64;
    const int sh = 2 * g, L = S >> sh, R0 = b * 256, P0 = R0 & (L - 1), seq0 = R0 - P0;
    const unsigned char* DILB = (const unsigned char*)(F.ws + WS_DIL); constexpr size_t TEN = (size_t)12 * S * 128 * 2;
    const size_t gh = (size_t)(g * 4 + h) * S;
    const unsigned char* Q8 = DILB + gh * 128; const float* NQ = (const float*)(DILB + DIL_NRM_OFF) + gh * 2;
    const unsigned char* K8 = DILB + TEN + (gh + seq0) * 128; const float* NK = (const float*)(DILB + TEN + DIL_NRM_OFF) + (gh + seq0) * 2;
    const bf16_t* Vg = (const bf16_t*)(DILB + 2 * TEN) + (gh + seq0) * 128;
    const int qlo = P0 + wid * 32, qm = qlo + r32 - 4 * hi;
    const int j0 = (qlo >= 128) ? 0 : ((128 - qlo) >> 5);
    const int skey = lane >> 4, sch = lane & 15, skey8 = lane >> 3, sch8 = lane & 7;
    u32x4 kreg[4], vreg[8]; f32x2 knrm;
    const unsigned kvo = (unsigned)(skey8 * 128 + sch8 * 16), vvo = (unsigned)(skey * 256 + sch * 16), nvo = (unsigned)(r32 * 8);
#define AT_LOADT(jj) do { const int kb_ = qlo - 128 + 32 * (jj); \
        const unsigned char* kt_ = K8 + (size_t)kb_ * 128; const unsigned char* vt_ = (const unsigned char*)Vg + (size_t)kb_ * 256; const unsigned char* nt_ = (const unsigned char*)NK + (size_t)kb_ * 8; \
        _Pragma("unroll") for (int i_ = 0; i_ < 4; ++i_) kreg[i_] = *(const u32x4*)(kt_ + kvo + i_ * 1024); \
        knrm = *(const f32x2*)(nt_ + nvo); \
        _Pragma("unroll") for (int i_ = 0; i_ < 8; ++i_) vreg[i_] = *(const u32x4*)(vt_ + vvo + i_ * 1024); } while (0)
    AT_LOADT(j0);
    at_i32x8 qr[2]; float rq;
    {
        const unsigned char* qrow = Q8 + (size_t)(R0 + wid * 32 + r32) * 128 + hi * 32;
#pragma unroll
        for (int m = 0; m < 2; ++m) { const at_i32x4 lo = *(const at_i32x4*)(qrow + m * 64), hi4 = *(const at_i32x4*)(qrow + m * 64 + 16); qr[m] = __builtin_shufflevector(lo, hi4, 0, 1, 2, 3, 4, 5, 6, 7); }
        const f32x2 nq = *(const f32x2*)(NQ + (size_t)(R0 + wid * 32 + r32) * 2);
        rq = __builtin_amdgcn_rsqf((nq.x + nq.y) * (1.0f / 128.0f) + EPS);
    }
    const int vb0 = (int)(unsigned)(size_t)V_lds + v_rd_base(lane);
    float m_reg = -1e30f, l_reg = 0.f; f32x16 o[4];
#pragma unroll
    for (int d = 0; d < 4; ++d)
#pragma unroll
        for (int r = 0; r < 16; ++r) o[d][r] = 0.f;
    const float SCq = AT_SCALE * rq, C2q = 1.4426950408889634f * SCq;
    const float Ms = __builtin_bit_cast(float, __builtin_amdgcn_readfirstlane(__builtin_bit_cast(int, 13.0f * *(const LAS float*)(F.lds + GWMAX_OFF)))); const bool fixed = Ms <= 80.0f;
    const float mnLfix = -Ms * 1.4426950408889634f;
#ifndef REPTILE
#define REPTILE 1
#endif
    for (int rt_ = 0; rt_ < REPTILE; ++rt_) {
    if (rt_ > 0) { m_reg = -1e30f; l_reg = 0.f;
#pragma unroll
        for (int d = 0; d < 4; ++d)
#pragma unroll
            for (int r = 0; r < 16; ++r) o[d][r] = 0.f;
        AT_LOADT(j0); }
    for (int j = j0; j < 5; ++j) {
        const int kb = qlo - 128 + 32 * j;
        asm volatile("s_waitcnt lgkmcnt(0)" ::: "memory");
#pragma unroll
        for (int i = 0; i < 4; ++i) *(LAS u32x4*)(K_lds + KSWZ8(8 * i + skey8, sch8 * 16)) = kreg[i];
#pragma unroll
        for (int i = 0; i < 8; ++i) *(LAS u32x4*)(V_lds + v_st(4 * i + skey, sch * 8)) = vreg[i];
        if (hi == 0) rk_l[r32] = __builtin_amdgcn_rsqf((knrm.x + knrm.y) * (1.0f / 128.0f) + EPS);
        if (j < 4) AT_LOADT(j + 1);
        asm volatile("s_waitcnt lgkmcnt(0)" ::: "memory");
        f32x16 p0;
#pragma unroll
        for (int r = 0; r < 16; ++r) p0[r] = 0.f;
#pragma unroll
        for (int m = 0; m < 2; ++m) { const int c0 = 4 * m + 2 * hi;
            const at_i32x4 lo = *(const LAS at_i32x4*)(K_lds + r32 * 128 + ((c0 ^ (r32 & 7)) << 4)), hi4 = *(const LAS at_i32x4*)(K_lds + r32 * 128 + (((c0 + 1) ^ (r32 & 7)) << 4));
            p0 = __builtin_amdgcn_mfma_scale_f32_32x32x64_f8f6f4(__builtin_shufflevector(lo, hi4, 0, 1, 2, 3, 4, 5, 6, 7), qr[m], p0, 0, 0, 0, 0, 0, 0); }
        if (j == 0 || j == 4) {
            const int dq = qm - kb; const float NEG = -__builtin_inff();
#pragma unroll
            for (int rg = 0; rg < 4; ++rg) { const f32x4 rk4 = *(const LAS f32x4*)(rk_l + 8 * rg + 4 * hi);
#pragma unroll
                for (int q = 0; q < 4; ++q) { const int r = 4 * rg + q, cc = q + 8 * rg; p0[r] = ((unsigned)(dq - cc) < (unsigned)AT_W) ? p0[r] * rk4[q] : NEG; } }
        } else {
#pragma unroll
            for (int rg = 0; rg < 4; ++rg) { const f32x4 rk4 = *(const LAS f32x4*)(rk_l + 8 * rg + 4 * hi);
#pragma unroll
                for (int q = 0; q < 4; ++q) p0[4 * rg + q] *= rk4[q]; }
        }
        float alpha = 1.f, mnL = mnLfix;
        if (!fixed) {
            float pmax = p0[0];
#pragma unroll
            for (int r = 1; r < 16; ++r) pmax = fmaxf(pmax, p0[r]);
            pmax = fmaxf(pmax, __shfl_xor(pmax, 32));
            float mn;
            if (__all((pmax - m_reg) * SCq <= AT_THR)) { mn = m_reg; }
            else { mn = fmaxf(m_reg, pmax); alpha = __builtin_amdgcn_exp2f((m_reg - mn) * C2q); m_reg = mn; }
            mnL = -mn * C2q;
        }
        float ps = 0.f;
#pragma unroll
        for (int r = 0; r < 16; ++r) { p0[r] = __builtin_amdgcn_exp2f(fmaf(p0[r], C2q, mnL)); ps += p0[r]; }
        ps += __shfl_xor(ps, 32);
        l_reg = l_reg * alpha + ps;
        bf16x8 pa0, pa1;
#define PK4(P, B_, OUT) do { unsigned a0 = cvt_pk_bf16(P[B_+0], P[B_+1]), a1 = cvt_pk_bf16(P[B_+2], P[B_+3]); \
        unsigned b0_ = cvt_pk_bf16(P[B_+4], P[B_+5]), b1_ = cvt_pk_bf16(P[B_+6], P[B_+7]); \
        auto r0_ = __builtin_amdgcn_permlane32_swap(a0, b0_, false, false); auto r1_ = __builtin_amdgcn_permlane32_swap(a1, b1_, false, false); \
        u32x4 w_ = {r0_[0], r1_[0], r0_[1], r1_[1]}; OUT = __builtin_bit_cast(bf16x8, w_); } while (0)
        PK4(p0, 0, pa0); PK4(p0, 8, pa1);
#undef PK4
        if (!fixed && __any(alpha < 1.f)) {
            if (hi == 0) al_l[r32] = alpha;
            LDS_WAIT();
#pragma unroll
            for (int rg = 0; rg < 4; ++rg) { const f32x4 a4 = *(const LAS f32x4*)(al_l + 8 * rg + 4 * hi);
#pragma unroll
                for (int q = 0; q < 4; ++q)
#pragma unroll
                    for (int d = 0; d < 4; ++d) o[d][4 * rg + q] *= a4[q]; }
        }
        at_pv32(o, vb0, pa0, pa1);
    }
    }
#undef AT_LOADT
    if (hi == 0) li_l[r32] = l_reg;
    LDS_WAIT();
    LAS unsigned char* O_lds = V_lds;
#pragma unroll
    for (int rg = 0; rg < 4; ++rg) { const f32x4 l4 = *(const LAS f32x4*)(li_l + 8 * rg + 4 * hi);
#pragma unroll
        for (int q = 0; q < 4; ++q) { const float rl = __builtin_amdgcn_rcpf(l4[q]); const int row = q + 8 * rg + 4 * hi, r = 4 * rg + q;
            *(LAS unsigned*)(O_lds + row * 128 + r32 * 4) = fp8x4((f32x4){o[0][r] * rl, o[1][r] * rl, o[2][r] * rl, o[3][r] * rl}); } }
    LDS_WAIT();
    unsigned char* OG8 = F.ws + WS_OG + (size_t)g * S * 512;
#pragma unroll
    for (int i = 0; i < 4; ++i) {
        const int id = lane + 64 * i, row = id >> 3, cc = id & 7;
        const int Rr = R0 + wid * 32 + row, tok = ((Rr & (L - 1)) << sh) + (Rr >> (14 - sh));
        *(u32x4*)(OG8 + (size_t)tok * 512 + h * 128 + cc * 16) = *(const LAS u32x4*)(O_lds + row * 128 + cc * 16);
    }
    if (hi == 0) {
        float* LSE = (float*)(F.ws + WS_LSE) + (size_t)g * S * 4;
        const int Rr = R0 + wid * 32 + r32; const int tok = ((Rr & (L - 1)) << sh) + (Rr >> (14 - sh));
        LSE[(size_t)tok * 4 + h] = (fixed ? Ms : m_reg * SCq) + logf(l_reg);
    }
    LDS_WAIT();
}

__device__ __forceinline__ void attn_combine(Frame& F) {
    const unsigned char* OG8 = F.ws + WS_OG; const float* LSE = (const float*)(F.ws + WS_LSE); bf16_t* YC = (bf16_t*)(F.ws + WS_YC);
    PHASE_IDS();
    const int gt = bid * 384 + (tid - 128), NGT = F.G * 384; constexpr int NIT = S * 16;
    for (int i0 = gt; i0 < NIT; i0 += 3 * NGT) {
        u32x4 a[3][2], bq[3][2], cq[3][2]; float l0[3], l1[3], l2[3];
#pragma unroll
        for (int k = 0; k < 3; ++k) {
            const int iu = i0 + k * NGT, i = iu < NIT ? iu : NIT - 1, tok = i >> 4, h = (i >> 2) & 3, c2 = i & 3; const size_t off = (size_t)tok * 512 + h * 128 + c2 * 32;
            l0[k] = LSE[(size_t)tok * 4 + h]; l1[k] = LSE[(size_t)S * 4 + (size_t)tok * 4 + h]; l2[k] = LSE[(size_t)2 * S * 4 + (size_t)tok * 4 + h];
#pragma unroll
            for (int hf = 0; hf < 2; ++hf) { a[k][hf] = *(const u32x4*)(OG8 + off + hf * 16); bq[k][hf] = *(const u32x4*)(OG8 + (size_t)S * 512 + off + hf * 16); cq[k][hf] = *(const u32x4*)(OG8 + (size_t)2 * S * 512 + off + hf * 16); }
        }
#pragma unroll
        for (int k = 0; k < 3; ++k) {
            const int i = i0 + k * NGT, tok = i >> 4, h = (i >> 2) & 3, c2 = i & 3;
            if (i >= NIT) continue;
            const float mx = fmaxf(l0[k], fmaxf(l1[k], l2[k]));
            float w0 = __expf(l0[k] - mx), w1 = __expf(l1[k] - mx), w2 = __expf(l2[k] - mx); const float inv = 1.0f / (w0 + w1 + w2); w0 *= inv; w1 *= inv; w2 *= inv;
            float y[4][8];
#pragma unroll
            for (int j = 0; j < 8; ++j) {
                const unsigned wa = a[k][j >> 2][j & 3], wb = bq[k][j >> 2][j & 3], wc_ = cq[k][j >> 2][j & 3];
                const f32x2 a01 = __builtin_amdgcn_cvt_pk_f32_fp8((int)wa, false), a23 = __builtin_amdgcn_cvt_pk_f32_fp8((int)wa, true);
                const f32x2 b01 = __builtin_amdgcn_cvt_pk_f32_fp8((int)wb, false), b23 = __builtin_amdgcn_cvt_pk_f32_fp8((int)wb, true);
                const f32x2 c01 = __builtin_amdgcn_cvt_pk_f32_fp8((int)wc_, false), c23 = __builtin_amdgcn_cvt_pk_f32_fp8((int)wc_, true);
                y[0][j] = w0 * a01.x + w1 * b01.x + w2 * c01.x; y[1][j] = w0 * a01.y + w1 * b01.y + w2 * c01.y;
                y[2][j] = w0 * a23.x + w1 * b23.x + w2 * c23.x; y[3][j] = w0 * a23.y + w1 * b23.y + w2 * c23.y;
            }
            bf16_t* yp = YC + (size_t)tok * 512 + h * 128 + c2 * 8;
#pragma unroll
            for (int kk = 0; kk < 4; ++kk) { u32x4 w; w.x = cvt_pk_bf16(y[kk][0], y[kk][1]); w.y = cvt_pk_bf16(y[kk][2], y[kk][3]); w.z = cvt_pk_bf16(y[kk][4], y[kk][5]); w.w = cvt_pk_bf16(y[kk][6], y[kk][7]);
                *(u32x4*)(yp + kk * 32) = w; }
        }
    }
}
#define XB_TMO      128
#define XB_XCNT(j)  (256  + 64 * (j))
#define XB_XSUB(j)  (1280 + 64 * (j))
#define XB_XGEN(j)  (2304 + 64 * (j))
#define XB_TOP      3328
#define XB_TOPGEN   3392
#define XCD_BAR_WORDS 3456
#define XB_SPIN_CAP (1u << 18)

__device__ __forceinline__ unsigned xb_ld(unsigned* p)              { return __hip_atomic_load(p, __ATOMIC_RELAXED, __HIP_MEMORY_SCOPE_AGENT); }
__device__ __forceinline__ unsigned xb_add(unsigned* p, unsigned v) { return __hip_atomic_fetch_add(p, v, __ATOMIC_RELAXED, __HIP_MEMORY_SCOPE_AGENT); }
__device__ __forceinline__ unsigned xb_xcc_id() { return (unsigned)__builtin_amdgcn_s_getreg((3 << 11) | 20) & 0xFu; }
#define XB_SPIN(cond, bar) do { unsigned _sp = 0; while (cond) { __builtin_amdgcn_s_sleep(1); \
    if ((++_sp & 255u) == 0u) { if (xb_ld(&(bar)[XB_TMO])) break; if (_sp > XB_SPIN_CAP) { atomicAdd(&(bar)[XB_TMO], 1u); break; } } } } while (0)

struct XcdBarrier {
    unsigned* bar; unsigned x;
    volatile LAS unsigned* st;
};

__device__ __forceinline__ XcdBarrier xcd_barrier_post(unsigned* bar, volatile LAS unsigned* st) {
    XcdBarrier b; b.bar = bar; b.x = xb_xcc_id(); b.st = st;
    if (threadIdx.x == 0) (void)xb_add(&bar[XB_XCNT(b.x)], 1u);
    return b;
}
__device__ __forceinline__ void xcd_barrier_complete(unsigned* bar, unsigned x, unsigned& nloc, unsigned& nx) {
    const unsigned G = gridDim.x * gridDim.y * gridDim.z;
    unsigned sum, cnt, mine, sp = 0u;
    for (;;) {
        sum = 0u; cnt = 0u; mine = 0u;
#pragma unroll
        for (unsigned j = 0; j < 16; ++j) { const unsigned c = xb_ld(&bar[XB_XCNT(j)]); sum += c; cnt += (c > 0u) ? 1u : 0u; mine = (j == x) ? c : mine; }
        if (sum == G) break;
        __builtin_amdgcn_s_sleep(1);
        if ((++sp & 255u) == 0u) { if (xb_ld(&bar[XB_TMO])) break; if (sp > XB_SPIN_CAP) { atomicAdd(&bar[XB_TMO], 1u); break; } }
    }
    nloc = mine > 0u ? mine : 1u; nx = cnt > 0u ? cnt : 1u;
}

__device__ __forceinline__ void xcd_barrier(const XcdBarrier& b) {
    asm volatile("s_waitcnt vmcnt(0)" ::: "memory");
    __syncthreads();
    if (threadIdx.x == 0) {
        unsigned* bar = b.bar;
        __builtin_amdgcn_s_waitcnt(0);
        unsigned nloc = b.st[0], nx = b.st[1];
        if (nloc == 0u) { xcd_barrier_complete(bar, b.x, nloc, nx); b.st[0] = nloc; b.st[1] = nx; }
        const unsigned old = xb_add(&bar[XB_XSUB(b.x)], 1u);
        const unsigned gen = old / nloc;
        if (old + 1u == (gen + 1u) * nloc) {
            __builtin_amdgcn_fence(__ATOMIC_RELEASE, "agent");
            asm volatile("s_waitcnt vmcnt(0)" ::: "memory");
            const unsigned og = xb_add(&bar[XB_TOP], 1u);
            const unsigned tg = og / nx;
#ifdef BAR_EARLY_INV
            if (og + 1u == (tg + 1u) * nx) { xb_add(&bar[XB_TOPGEN], 1u); asm volatile("buffer_inv sc1" ::: "memory"); }
            else { asm volatile("buffer_inv sc1" ::: "memory"); XB_SPIN(xb_ld(&bar[XB_TOPGEN]) == tg, bar); }
#else
            if (og + 1u == (tg + 1u) * nx) xb_add(&bar[XB_TOPGEN], 1u);
            else XB_SPIN(xb_ld(&bar[XB_TOPGEN]) == tg, bar);
#endif
#ifndef BAR_EARLY_INV
            __builtin_amdgcn_fence(__ATOMIC_ACQUIRE, "agent");
#endif
            asm volatile("s_waitcnt vmcnt(0)" ::: "memory");
        } else {
#ifdef BAR_EARLY_INV
            asm volatile("buffer_inv sc1" ::: "memory");
#endif
            XB_SPIN(xb_ld(&bar[XB_TOPGEN]) == gen, bar);
#ifndef BAR_EARLY_INV
            __builtin_amdgcn_fence(__ATOMIC_ACQUIRE, "agent");
#endif
            asm volatile("s_waitcnt vmcnt(0)" ::: "memory");
        }
    }
    __syncthreads();
}

struct Args { const float* in[15]; float* out; unsigned char* ws; int ph_lo, ph_hi, li, pad; };
__global__ void __launch_bounds__(NTHREADS, 2) trunk_fwd(Args args) {
    extern __shared__ __attribute__((aligned(16))) unsigned char lds_raw[];
    Frame F;
    F.lds = (LAS unsigned char*)lds_raw;
    F.tid = threadIdx.x;
    F.G = gridDim.x; F.bid = blockIdx.x;
    F.ws = args.ws;
    volatile LAS unsigned* MISC = (volatile LAS unsigned*)(F.lds + MISC_OFF);
    if (F.tid < 16) MISC[F.tid] = 0u;
    if (F.tid == 64) { const float* LAS* tb = (const float* LAS*)(F.lds + MISC_OFF + 64);
        tb[0] = args.in[0]; tb[1] = args.in[1]; tb[2] = args.in[2]; tb[3] = args.in[3]; tb[4] = args.in[4]; tb[5] = args.in[5]; tb[6] = args.in[6]; tb[7] = args.in[7];
        tb[8] = args.in[8]; tb[9] = args.in[9]; tb[10] = args.in[10]; tb[11] = args.in[11]; tb[12] = args.in[12]; tb[13] = args.in[13]; tb[14] = args.in[14]; tb[15] = args.out; }
    __syncthreads();
    unsigned* ctl = (unsigned*)(F.ws + WS_CTL);
    XcdBarrier bar; bar.bar = ctl + CW_BAR; bar.x = 0; bar.st = nullptr;
    if (MK_N_LAUNCHES == 1) bar = xcd_barrier_post(ctl + CW_BAR, MISC);
#ifdef PROBE_BAR2
#define GRID_BAR() do { if (MK_N_LAUNCHES == 1) { xcd_barrier(bar); xcd_barrier(bar); } } while (0)
#else
#define GRID_BAR() do { if (MK_N_LAUNCHES == 1) xcd_barrier(bar); } while (0)
#endif
#define OPAQUE_BID() Frame& P = F; const int pbid = F.bid
#ifndef ATT_XCD_DEAL
#define ATT_XCD_DEAL 0
#endif
#ifndef GSP2
#define GSP2 true
#endif
#ifndef F8SEL
#define F8SEL true
#endif
#ifndef GSP2_F8
#define GSP2_F8 GSP2
#endif
#ifndef ALIGN_F8
#define ALIGN_F8 true
#endif
#ifndef ALIGN_IN
#define ALIGN_IN true
#endif
#ifndef STAGGER_TICKS
#define STAGGER_TICKS 0
#endif
#define STAGGER(ntn) do { if (STAGGER_TICKS > 0 && (pbid & 32)) { for (int i_ = 0; i_ < STAGGER_TICKS; ++i_) __builtin_amdgcn_s_sleep(12); } } while (0)
#if MK_N_LAUNCHES == 1
    constexpr int lo = 0, hi = N_PHASES;
#else
    const int lo = args.ph_lo, hi = args.ph_hi;
#endif
#ifndef PHMASK
#define PHMASK 0x1ff
#endif
#define PHON(j) (((PHMASK) >> (j)) & 1)
#ifndef REPMASK
#define REPMASK 0
#endif
#define NREP(j) (1 + (((REPMASK) >> (j)) & 1))
#ifndef REPSUB
#define REPSUB 0
#endif
#define NSUB(j) (1 + (((REPSUB) >> (j)) & 1))
#define IN(k) (lo <= (k) && (k) < hi)
#define BOTH(k) (IN(k) && IN((k) + 1))

    for (int rep_ = 0; rep_ < NREP(0); ++rep_) if (PHON(0) && IN(0)) { p0_prologue(F); if (BOTH(0)) GRID_BAR(); }

#define ssq_mix ((float*)(P.ws + WS_SSQ))
#define ssq_ffn ((float*)(P.ws + WS_SSQ + 1 * MiB))
#define XB ((bf16_t*)(P.ws + WS_XB))
#define wl (P.ws + WS_W + (size_t)l * W_LAYER_B)
    for (int l = 0; l < DEPTH; ++l) {
        const int pb0 = 1 + l * PH_PER_LAYER;
        for (int rep_ = 0; rep_ < NREP(1); ++rep_) if (PHON(1) && IN(pb0 + 0)) { OPAQUE_BID(); STAGGER(0);
#if F8_TILES == 6
            pg8::Gemm g8{(const bf16_t*)(P.ws + WS_XB8), (const bf16_t*)(P.ws + WS_XB8), (const bf16_t*)(P.ws + WS_XB8), (const bf16_t*)(wl + WOFF_IN8), 0, D / 2};
            pg8::StaticOrder So8; So8.init(S, 30 * 256, P.G, pbid, 1, 12); So8.gap(1 << 20, 0, 1);
            pg8::Gemm g{XB, XB, XB, (const bf16_t*)(wl + WOFF_IN), 0, D}; pg8::StaticOrder So; So.init(S, 12 * 256, P.G, pbid);
            constexpr int NBF = 30;
#elif F8_TILES == 5
            pg8::Gemm g8{(const bf16_t*)(P.ws + WS_XB8), (const bf16_t*)(P.ws + WS_XB8), (const bf16_t*)(P.ws + WS_XB8), (const bf16_t*)(wl + WOFF_IN8), 0, D / 2};
            pg8::StaticOrder So8; So8.init(S, 22 * 256, P.G, pbid, 1, 12); So8.gap(18, 8, 1);
            pg8::Gemm g{XB, XB, XB, (const bf16_t*)(wl + WOFF_IN), 0, D}; pg8::StaticOrder So; So.init(S, 20 * 256, P.G, pbid); So.gap(12, 18, 0);
            constexpr int NBF = 22;
#define F8_LAST 1
#elif F8_TILES == 4
            pg8::Gemm g8{(const bf16_t*)(P.ws + WS_XB8), (const bf16_t*)(P.ws + WS_XB8), (const bf16_t*)(P.ws + WS_XB8), (const bf16_t*)(wl + WOFF_IN8), 0, D / 2};
            pg8::StaticOrder So8; So8.init(S, 24 * 256, P.G, pbid); So8.gap(6, 6, 1);
            pg8::Gemm g{XB, XB, XB, (const bf16_t*)(wl + WOFF_IN), 0, D}; pg8::StaticOrder So; So.init(S, 18 * 256, P.G, pbid, 1, 6); So.gap(6, 18, 0);
            constexpr int NBF = 18;
#elif F8_TILES == 3
            pg8::Gemm g8{(const bf16_t*)(P.ws + WS_XB8), (const bf16_t*)(P.ws + WS_XB8), (const bf16_t*)(P.ws + WS_XB8), (const bf16_t*)(wl + WOFF_IN8), 0, D / 2};
            pg8::StaticOrder So8; So8.init(S, 24 * 256, P.G, pbid, 1, 12); So8.gap(12, 6, 1);
            pg8::Gemm g{XB, XB, XB, (const bf16_t*)(wl + WOFF_IN), 0, D}; pg8::StaticOrder So; So.init(S, 18 * 256, P.G, pbid); So.gap(12, 12, 0);
            constexpr int NBF = 18;
#elif F8_TILES == 2
            pg8::Gemm g8{(const bf16_t*)(P.ws + WS_XB8), (const bf16_t*)(P.ws + WS_XB8), (const bf16_t*)(P.ws + WS_XB8), (const bf16_t*)(wl + WOFF_IN8 + (size_t)12 * 256 * D), 0, D / 2};
            pg8::StaticOrder So8; So8.init(S, 12 * 256, P.G, pbid, 1, 30); So8.gap(1 << 20, 0, 1);
            pg8::Gemm g{XB, XB, XB, (const bf16_t*)(wl + WOFF_IN), 0, D}; pg8::StaticOrder So; So.init(S, 30 * 256, P.G, pbid);
            constexpr int NBF = 30;
#else
            pg8::Gemm g8{(const bf16_t*)(P.ws + WS_XB8), (const bf16_t*)(P.ws + WS_XB8), (const bf16_t*)(P.ws + WS_XB8), (const bf16_t*)(wl + WOFF_IN8), 0, D / 2};
            pg8::StaticOrder So8; So8.init(S, 12 * 256, P.G, pbid, 1, 12); So8.gap(1 << 20, 0, 1);
            pg8::Gemm g{XB, XB, XB, (const bf16_t*)(wl + WOFF_IN), 0, D}; pg8::StaticOrder So; So.init(S, 30 * 256, P.G, pbid); So.gap(12, 12, 0);
            constexpr int NBF = 30;
#endif
            const RstdHook rh{P, ssq_mix, inp(P, IN_DILQG) + l * 128, inp(P, IN_DILKG) + l * 128};
            EpiIn E{(const LAS float*)(P.lds + RSTD_OFF), (const float*)(P.ws + WS_CS), (bf16_t*)(P.ws + WS_SEG), (bf16_t*)(P.ws + WS_DIL), (unsigned char*)(P.ws + WS_GT), (const LAS float*)(P.lds + GW_OFF)};
#ifdef PROBE_KLOOP
            if (PROBE_KLOOP & 1) { EpiNull En; pg8::gemm_phase<EpiNull, pg8::StaticOrder, true, GSP2>(P.lds, g, So, En); __syncthreads(); }
#endif
#ifdef F8_LAST
            pg8::gemm_phase<EpiIn, pg8::StaticOrder, ALIGN_IN, GSP2, false, false, RstdHook>(P.lds, g, So, E, rh);
            pg8::gemm_phase<EpiIn, pg8::StaticOrder, ALIGN_F8, GSP2_F8, false, F8SEL>(P.lds, g8, So8, E);
#else
            pg8::gemm_phase<EpiIn, pg8::StaticOrder, ALIGN_F8, GSP2_F8, false, F8SEL, RstdHook>(P.lds, g8, So8, E, rh);
            pg8::gemm_phase<EpiIn, pg8::StaticOrder, ALIGN_IN, GSP2>(P.lds, g, So, E);
#endif
            p0_side(P, l, 0, (S / 256) * NBF);
            if (BOTH(pb0 + 0)) GRID_BAR();
        }
        for (int rep_ = 0; rep_ < NREP(2); ++rep_) if (PHON(2) && IN(pb0 + 1)) { OPAQUE_BID();
            for (int rs_ = 0; rs_ < NSUB(0); ++rs_) for (int u = pbid; u < 768; u += P.G) { const int g = u >> 8, r = u & 255; attn_unit(P, l, g, r >> 6, r & 63); }
            __syncthreads();
            { const int hg = P.G >> 1;
              if (pbid < hg) { for (int rs_ = 0; rs_ < NSUB(1); ++rs_) for (int c = pbid; c < 128; c += hg) sg_chunk(P, l, c); }
              else { for (int rs_ = 0; rs_ < NSUB(2); ++rs_) ret_kv_units(P, pbid - hg, P.G - hg); } }
            if (BOTH(pb0 + 1)) GRID_BAR();
        }
        for (int rep_ = 0; rep_ < NREP(3); ++rep_) if (PHON(3) && IN(pb0 + 2)) { OPAQUE_BID();
            if (__builtin_amdgcn_readfirstlane(P.tid >> 6) < 2) { for (int rs_ = 0; rs_ < NSUB(3); ++rs_) ret_scan(F); }
            else { for (int rs_ = 0; rs_ < NSUB(4); ++rs_) attn_combine(F); }
            if (BOTH(pb0 + 2)) GRID_BAR();
        }
        for (int rep_ = 0; rep_ < NREP(4); ++rep_) if (PHON(4) && IN(pb0 + 3)) { OPAQUE_BID();
            for (int rs_ = 0; rs_ < NSUB(5); ++rs_) ret_out_units(P, l, pbid, P.G);
            if (BOTH(pb0 + 3)) GRID_BAR();
        }
        for (int rep_ = 0; rep_ < NREP(5); ++rep_) if (PHON(5) && IN(pb0 + 4)) { OPAQUE_BID();
            pg8::Gemm g{(const bf16_t*)(P.ws + WS_YA), (const bf16_t*)(P.ws + WS_YB), (const bf16_t*)(P.ws + WS_YC), (const bf16_t*)(wl + WOFF_B), (size_t)D * 512, 512};
            pg8::StaticOrder So; So.init(S, D, P.G, pbid, 3);
            EpiMerge E{(const unsigned char*)(P.ws + WS_GT), (bf16_t*)(P.ws + WS_MERGED)};
            pg8::gemm_phase<EpiMerge, pg8::StaticOrder, true, GSP2>(P.lds, g, So, E);
            if (BOTH(pb0 + 4)) GRID_BAR();
        }
        for (int rep_ = 0; rep_ < NREP(6); ++rep_) if (PHON(6) && IN(pb0 + 5)) { OPAQUE_BID();
            const bf16_t* A = (const bf16_t*)(P.ws + WS_MERGED);
            pg8::Gemm g{A, A, A, (const bf16_t*)(wl + WOFF_O), 0, D}; pg8::StaticOrder So; So.init(S, D, P.G, pbid);
            EpiRes E{(l == 0) ? inp(P, IN_X) : (const float*)nullptr, (float*)nullptr, XB, ssq_ffn, (unsigned char*)nullptr};
#ifdef PROBE_KLOOP
            if (PROBE_KLOOP & 8) { EpiNull En; pg8::gemm_phase<EpiNull, pg8::StaticOrder, false, GSP2>(P.lds, g, So, En); __syncthreads(); }
#endif
            pg8::gemm_phase<EpiRes, pg8::StaticOrder, false, GSP2>(P.lds, g, So, E);
            if (BOTH(pb0 + 5)) GRID_BAR();
        }
        for (int rep_ = 0; rep_ < NREP(7); ++rep_) if (PHON(7) && IN(pb0 + 6)) { OPAQUE_BID(); STAGGER(0);
            pg8::Gemm g{XB, XB, XB, (const bf16_t*)(wl + WOFF_GU), 0, D}; pg8::StaticOrder So; So.init(S, NGU, P.G, pbid);
            const RstdHook rh{P, ssq_ffn, nullptr, nullptr};
            EpiGU E{(const LAS float*)(P.lds + RSTD_OFF), (bf16_t*)(P.ws + WS_ACT)};
#ifdef PROBE_KLOOP
            if (PROBE_KLOOP & 2) { EpiNull En; pg8::gemm_phase<EpiNull, pg8::StaticOrder, true, GSP2>(P.lds, g, So, En); __syncthreads(); }
#endif
            pg8::gemm_phase<EpiGU, pg8::StaticOrder, ALIGN_IN, GSP2, false, false, RstdHook>(P.lds, g, So, E, rh);
            p0_side(P, l, 1, (S / 256) * (NGU / 256));
            if (BOTH(pb0 + 6)) GRID_BAR();
        }
        for (int rep_ = 0; rep_ < NREP(8); ++rep_) if (PHON(8) && IN(pb0 + 7)) { OPAQUE_BID();
            const bf16_t* A = (const bf16_t*)(P.ws + WS_ACT);
            pg8::Gemm g{A, A, A, (const bf16_t*)(wl + WOFF_D), 0, DFF}; pg8::StaticOrder So; So.init(S, D, P.G, pbid);
            EpiRes E{(const float*)nullptr, (l == DEPTH - 1) ? (float*)inp(P, IN_OUT) : (float*)nullptr, XB, ssq_mix, (l == DEPTH - 1) ? (unsigned char*)nullptr : P.ws + WS_XB8};
#ifdef PROBE_KLOOP
            if (PROBE_KLOOP & 4) { EpiNull En; pg8::gemm_phase<EpiNull, pg8::StaticOrder, false, GSP2>(P.lds, g, So, En); __syncthreads(); }
#endif
            pg8::gemm_phase<EpiRes, pg8::StaticOrder, false, GSP2>(P.lds, g, So, E);
            if (BOTH(pb0 + 7)) GRID_BAR();
        }
    }
#undef IN
#undef BOTH
#undef ssq_mix
#undef ssq_ffn
#undef XB
#undef wl
}

extern "C" void kernel_launch(void* const* d_in, const int* in_sizes, int n_in, void* d_out, int out_size, void* d_ws, size_t ws_size, hipStream_t stream) {
    static int grid = 0;
    if (grid == 0) {
        if (n_in != 15 || in_sizes[0] != S * D || out_size != S * D || ws_size < WS_END) { fprintf(stderr, "kernel_launch: unexpected shapes (n_in %d, in0 %d, out %d, ws %zu); nothing launched\n", n_in, n_in > 0 ? in_sizes[0] : -1, out_size, ws_size); grid = -1; return; }
        int dev = 0, cus = 0, per_cu = 0;
        if (hipGetDevice(&dev) != hipSuccess || hipDeviceGetAttribute(&cus, hipDeviceAttributeMultiprocessorCount, dev) != hipSuccess) { grid = -1; return; }
        if (hipFuncSetAttribute((const void*)trunk_fwd, hipFuncAttributeMaxDynamicSharedMemorySize, LDS_BYTES) != hipSuccess) { fprintf(stderr, "kernel_launch: hipFuncSetAttribute failed\n"); grid = -1; return; }
        if (hipOccupancyMaxActiveBlocksPerMultiprocessor(&per_cu, (const void*)trunk_fwd, NTHREADS, LDS_BYTES) != hipSuccess || per_cu < 1)
            fprintf(stderr, "kernel_launch: note: occupancy query reports %d workgroups per CU\n", per_cu);
        (void)hipGetLastError();
        grid = cus & ~7;
    }
    if (grid < 0) return;
    if (hipMemsetAsync((char*)d_ws + WS_CTL, 0, CTL_ZERO_BYTES, stream) != hipSuccess) { fprintf(stderr, "kernel_launch: memset failed\n"); return; }
    Args a{};
    for (int i = 0; i < 15; ++i) a.in[i] = (const float*)d_in[i];
    a.out = (float*)d_out; a.ws = (unsigned char*)d_ws; a.pad = 0;
#if MK_N_LAUNCHES == 1
    a.ph_lo = 0; a.ph_hi = N_PHASES; a.li = 0;
    hipLaunchKernelGGL(trunk_fwd, dim3(grid), dim3(NTHREADS), LDS_BYTES, stream, a);
#else
    for (int p = 0; p < N_PHASES; ++p) { a.ph_lo = p; a.ph_hi = p + 1; a.li = 0; hipLaunchKernelGGL(trunk_fwd, dim3(grid), dim3(NTHREADS), LDS_BYTES, stream, a); }
#endif
    const hipError_t le = hipPeekAtLastError();
    if (le != hipSuccess) fprintf(stderr, "kernel_launch: launch failed: %s\n", hipGetErrorName(le));
}
```

```cpp
#include <hip/hip_runtime.h>
#include <cstdio>
#include <cstdint>

#define LAS __attribute__((address_space(3)))
#define GAS __attribute__((address_space(1)))
typedef unsigned short bf16_t;
typedef short bf16x8 __attribute__((ext_vector_type(8)));
typedef short s16x4 __attribute__((ext_vector_type(4)));
typedef float f32x2 __attribute__((ext_vector_type(2)));
typedef float f32x4 __attribute__((ext_vector_type(4)));
typedef float f32x16 __attribute__((ext_vector_type(16)));
typedef unsigned u32x2 __attribute__((ext_vector_type(2)));
typedef unsigned u32x4 __attribute__((ext_vector_type(4)));

constexpr int S = 16384, D = 1024, DEPTH = 4, NIN = 10752, DFF = 2816, NGU = 2 * DFF;
constexpr float EPS = 1e-6f;
constexpr int NWAVES = 8, NTHREADS = 512;

#ifndef MK_N_LAUNCHES
#define MK_N_LAUNCHES 1
#endif
constexpr int PH_PER_LAYER = 8;
constexpr int N_PHASES = 1 + DEPTH * PH_PER_LAYER;

constexpr size_t MiB = 1u << 20;
constexpr size_t WS_CTL = 0, CTL_ZERO_BYTES = 1 * MiB;
constexpr size_t W_IN_B = (size_t)NIN * D * 2, W_B_B = (size_t)3 * D * 512 * 2, W_O_B = (size_t)D * D * 2, W_GU_B = (size_t)NGU * D * 2, W_D_B = (size_t)D * DFF * 2, W_SG_B = (size_t)4 * 128 * 128 * 2;
constexpr size_t WOFF_IN = 0, WOFF_B = WOFF_IN + W_IN_B, WOFF_O = WOFF_B + W_B_B, WOFF_GU = WOFF_O + W_O_B, WOFF_D = WOFF_GU + W_GU_B, WOFF_SG = WOFF_D + W_D_B, W_LAYER_B = WOFF_SG + W_SG_B;
constexpr size_t WOFF_IN8 = WOFF_IN + (size_t)3072 * D * 2;
constexpr size_t WS_W = 1 * MiB;
constexpr size_t WS_CS = 172 * MiB;
constexpr size_t WS_SSQ = 180 * MiB;
constexpr size_t WS_XB = 182 * MiB;
constexpr size_t WS_SEG = 214 * MiB;
constexpr size_t WS_ACT = 214 * MiB;
constexpr size_t WS_DIL = 310 * MiB;
constexpr size_t DIL_NRM_OFF = (size_t)12 * S * 128;
constexpr size_t WS_RP = 310 * MiB, WS_YA = 326 * MiB, WS_YC = 342 * MiB, WS_MERGED = 358 * MiB;
constexpr int GT_LD = 3072 + 64;
constexpr size_t WS_GT = 454 * MiB;
constexpr size_t WS_KVT = 552 * MiB;
constexpr size_t WS_OG = 584 * MiB;
constexpr size_t WS_LSE = 632 * MiB;
constexpr size_t WS_YB = 633 * MiB;
constexpr size_t WS_XB8 = 649 * MiB;
constexpr size_t WS_END = 665 * MiB;
static_assert(WS_W + DEPTH * W_LAYER_B <= WS_CS, "weights fit");
static_assert(WS_SEG + 6 * (size_t)S * 512 * 2 <= WS_DIL && WS_ACT + (size_t)S * DFF * 2 <= WS_DIL, "seg/act");
static_assert(WS_DIL + 3 * (size_t)12 * S * 128 * 2 <= WS_GT && WS_MERGED + (size_t)S * D * 2 <= WS_GT && WS_MERGED >= WS_DIL + (size_t)12 * S * 128 * 2, "dil");
static_assert(WS_GT + (size_t)S * GT_LD <= WS_KVT && WS_KVT + (size_t)512 * 16384 * 4 <= WS_OG && WS_OG + 3 * (size_t)S * 512 * 2 <= WS_LSE, "map");
constexpr int CW_BAR = 4096;

constexpr int LDS_SCRATCH = 147456;
constexpr int GWMAX_OFF = LDS_SCRATCH - 8192 - 512 - 16;
constexpr int GW_OFF = LDS_SCRATCH - 8192 - 512;
constexpr int RSTD_OFF = LDS_SCRATCH - 8192;
constexpr int MISC_OFF = LDS_SCRATCH;
constexpr int LDS_BYTES = LDS_SCRATCH + 256;

typedef __bf16 bf16x2_t __attribute__((ext_vector_type(2)));
__device__ __forceinline__ unsigned cvt_pk_bf16(float lo, float hi) { const f32x2 v = {lo, hi}; const bf16x2_t b = __builtin_convertvector(v, bf16x2_t); return __builtin_bit_cast(unsigned, b); }
__device__ __forceinline__ float bf_lo(unsigned u) { return __uint_as_float(u << 16); }
__device__ __forceinline__ float bf_hi(unsigned u) { return __uint_as_float(u & 0xffff0000u); }
__device__ __forceinline__ float bf2f(bf16_t b) { return __uint_as_float(((unsigned)b) << 16); }
__device__ __forceinline__ bf16_t f2bf(float f) { return (bf16_t)(cvt_pk_bf16(f, 0.f) & 0xffffu); }
__device__ __forceinline__ float fast_exp(float x) { return __builtin_amdgcn_exp2f(x * 1.4426950408889634f); }
__device__ __forceinline__ float sigmoidf_(float x) { return __builtin_amdgcn_rcpf(1.0f + fast_exp(-x)); }
__device__ __forceinline__ float siluf_(float x) { return x * sigmoidf_(x); }
__device__ __forceinline__ float geluf_(float x) { const float u = 0.7978845608028654f * (x + 0.044715f * x * x * x); return x * sigmoidf_(2.0f * u); }
__device__ __forceinline__ float sum_fq(float s) {
    const unsigned u = __float_as_uint(s); const auto r = __builtin_amdgcn_permlane16_swap(u, u, false, false);
    const float t = __uint_as_float(r[0]) + __uint_as_float(r[1]); const unsigned v = __float_as_uint(t); const auto r2 = __builtin_amdgcn_permlane32_swap(v, v, false, false);
    return __uint_as_float(r2[0]) + __uint_as_float(r2[1]);
}
#define LDS_WAIT() asm volatile("s_waitcnt lgkmcnt(0)" ::: "memory")
#define VM_WAIT() asm volatile("s_waitcnt vmcnt(0)" ::: "memory")

#ifndef BAR_EARLY_INV
#define BAR_EARLY_INV 1
#endif
#ifndef F8_TILES
#define F8_TILES 6
#endif
#ifndef WGM_V
#define WGM_V 2
#endif
typedef int pg8_i32x4 __attribute__((ext_vector_type(4)));
namespace pg8 {
#define PG8_LAS __attribute__((address_space(3)))
constexpr int BM = 256, BK = 64, HALF = 128, HTB = HALF * BK * 2  , STAGE_BYTES = 8 * HTB, NXCD = 8, WGM = WGM_V;

__host__ __device__ __forceinline__ int lds_byte(int r, int c) { const int st = (r >> 4) * 2 + (c >> 5), rr = r & 15, cc = c & 31, ob = rr * 64 + cc * 2; return st * 1024 + (ob ^ (((ob >> 9) & 1) << 5)); }
__host__ __device__ __forceinline__ void stage_rc(int b, int& R, int& C) { const int st = b / 1024, sb = b % 1024, swz = sb ^ (((sb >> 9) & 1) << 5); R = (st >> 1) * 16 + swz / 64; C = (st & 1) * 32 + (swz % 64) / 2; }
__host__ __device__ __forceinline__ int perm32(int rho) { const int n = rho >> 4, i = rho & 15; return 8 * (i >> 2) + 4 * n + (i & 3); }

struct Unit { int pm, pn, pb, hf, pnb; };
struct Gemm { const bf16_t* A0; const bf16_t* A1; const bf16_t* A2; const bf16_t* Bt; size_t bstride; int K;
    __device__ __forceinline__ const char* a_ptr(const Unit& u) const { const bf16_t* a = (u.pb == 0) ? A0 : ((u.pb == 1) ? A1 : A2); return (const char*)(a + ((size_t)u.pm * BM + (u.hf == 2 ? HALF : 0)) * K); }
    __device__ __forceinline__ const char* b_ptr(const Unit& u) const { return (const char*)(Bt + (size_t)u.pb * bstride + (size_t)u.pnb * BM * K); }
};

struct StaticOrder {
    int nM, nN, nwg, G, c, NB, pn0, hv, gap_at, gap_len, dense;
    __device__ void init(int M, int N, int G_, int c_, int NB_ = 1, int pn0_ = 0, int hv_ = 0) { nM = M / BM; nN = N / BM; nwg = nM * nN; G = G_; c = c_; NB = NB_; pn0 = pn0_; hv = hv_; gap_at = 1 << 20; gap_len = 0; dense = 0; }
    __device__ void gap(int at, int len, int dense_) { gap_at = at; gap_len = len; dense = dense_; }
    __device__ bool next(int i, Unit& u) const {
        const int it = i / NB; u.pb = i - it * NB; u.hf = 0;
        long L = (long)it * G + c;
        if (hv) { if (L >= 2L * nwg) return false; u.hf = 1 + (int)(L & 1); L >>= 1; }
        if (L >= nwg) return false;
        int wgid = (int)L; { const int q = nwg / NXCD, r = nwg % NXCD, xcd = wgid % NXCD, off = wgid / NXCD; wgid = (xcd < r ? xcd * (q + 1) : r * (q + 1) + (xcd - r) * q) + off; }
        const int nig = WGM * nN, gid = wgid / nig, fm = gid * WGM, gsz = (nM - fm) < WGM ? (nM - fm) : WGM;
        u.pm = fm + ((wgid % nig) % gsz); { const int pl = (wgid % nig) / gsz; u.pn = pn0 + pl + (pl >= gap_at ? gap_len : 0); u.pnb = dense ? pl : u.pn; } return true;
    }
    __device__ __forceinline__ void a_ready(const Unit&) const {}
    __device__ __forceinline__ void done(const Unit&) const {}
};

struct NoPre { __device__ __forceinline__ void operator()() const {} };
template <class Epi, class Sched, bool ALIGN_EPI = false, bool SP2 = false, bool HF = false, bool F8 = false, class Pre = NoPre>
__device__ __forceinline__ void gemm_phase(PG8_LAS unsigned char* lds, const Gemm g, const Sched& S, const Epi& E, const Pre& pre = Pre()) {
    int tid = threadIdx.x; asm volatile("" : "+v"(tid));
    const int wid = __builtin_amdgcn_readfirstlane(tid >> 6), lane = tid & 63, wr = wid >> 2, wc = wid & 3, fr = lane & 15, fq = lane >> 4;
    const int K = g.K, nt = K / BK;
    unsigned voffA[2], voffB[2];
#pragma unroll
    for (int i = 0; i < 2; ++i) { int R, C; stage_rc(tid * 16 + i * 8192, R, C); const int Rb = Epi::PERM ? ((R & ~31) + perm32(R & 31)) : R;
        voffA[i] = (unsigned)(R * K + C) * 2u; voffB[i] = (unsigned)(Rb * K + C) * 2u; }
    const size_t kstep = (size_t)(BK * 2);
    const size_t hstep = (size_t)HALF * K * 2;
    const unsigned ldsw = (unsigned)wid * 1024u;
    const int aoff = lds_byte(wr * 64 + fr, fq * 8), boff = lds_byte(wc * 32 + fr, fq * 8);
#define PG8_SA(b, h) (((b) * 2 + (h)) * HTB)
#define PG8_SB(b, h) ((4 + (b) * 2 + (h)) * HTB)
#define PG8_STAGE(bufoff, gbase, voff) do { _Pragma("unroll") for (int _i = 0; _i < 2; ++_i) \
        __builtin_amdgcn_global_load_lds((const unsigned*)((const char*)(gbase) + (voff)[_i]), (PG8_LAS unsigned*)(lds + (bufoff) + ldsw + _i * 8192), 16, 0, 0); } while (0)
#define PG8_LDA(dst, b, h) do { _Pragma("unroll") for (int m = 0; m < 4; ++m) _Pragma("unroll") for (int k = 0; k < 2; ++k) dst[m][k] = *(const PG8_LAS bf16x8*)(lds + PG8_SA(b, h) + aoff + m * 2048 + k * 1024); } while (0)
#define PG8_LDB(dst, b, h) do { _Pragma("unroll") for (int n = 0; n < 2; ++n) _Pragma("unroll") for (int k = 0; k < 2; ++k) dst[n][k] = *(const PG8_LAS bf16x8*)(lds + PG8_SB(b, h) + boff + n * 2048 + k * 1024); } while (0)
#define PG8_CAT8(x) __builtin_shufflevector(__builtin_bit_cast(pg8_i32x4, (x)[0]), __builtin_bit_cast(pg8_i32x4, (x)[1]), 0, 1, 2, 3, 4, 5, 6, 7)
#define PG8_MMA(ai, bj, At, Bt) do { __builtin_amdgcn_s_setprio(1); \
        if constexpr (F8) { _Pragma("unroll") for (int m = 0; m < 4; ++m) _Pragma("unroll") for (int n = 0; n < 2; ++n) \
            asm volatile("v_mfma_f32_16x16x128_f8f6f4 %0, %1, %2, %0" : "+v"(acc[ai][bj][m][n]) : "v"(PG8_CAT8(Bt[n])), "v"(PG8_CAT8(At[m]))); } \
        else { _Pragma("unroll") for (int m = 0; m < 4; ++m) _Pragma("unroll") for (int n = 0; n < 2; ++n) _Pragma("unroll") for (int k = 0; k < 2; ++k) \
            acc[ai][bj][m][n] = __builtin_amdgcn_mfma_f32_16x16x32_bf16(Bt[n][k], At[m][k], acc[ai][bj][m][n], 0, 0, 0); } \
        __builtin_amdgcn_s_setprio(0); } while (0)
#define PG8_WAIT_V(n) asm volatile("s_waitcnt vmcnt(" #n ")" ::: "memory")
#define PG8_WAIT_L(n) asm volatile("s_waitcnt lgkmcnt(" #n ")" ::: "memory")
#define PG8_BAR __builtin_amdgcn_s_barrier()
#define PG8_SCHED __builtin_amdgcn_sched_barrier(0)
    Unit cur, nxt; int ui = 0;
    if (!S.next(0, cur)) return;
    f32x4 acc[2][2][4][2];
#pragma unroll
    for (int a = 0; a < 2; ++a)
#pragma unroll
        for (int b = 0; b < 2; ++b)
#pragma unroll
            for (int m = 0; m < 4; ++m)
#pragma unroll
                for (int n = 0; n < 2; ++n) acc[a][b][m][n] = (f32x4){0.f, 0.f, 0.f, 0.f};
    bf16x8 At[4][2], B0[2][2], B1[2][2];
    const char* cA = g.a_ptr(cur); const char* cB = g.b_ptr(cur);
    S.a_ready(cur);
    if constexpr (SP2) {
        PG8_STAGE(PG8_SB(0, 0), cB, voffB); PG8_STAGE(PG8_SB(0, 1), cB + hstep, voffB); PG8_STAGE(PG8_SA(0, 0), cA, voffA); PG8_STAGE(PG8_SA(0, 1), cA + hstep, voffA);
        pre();
        if (wr == 1) PG8_BAR;
        PG8_WAIT_V(2); PG8_BAR;
        PG8_STAGE(PG8_SB(1, 0), cB + kstep, voffB); PG8_STAGE(PG8_SA(1, 0), cA + kstep, voffA); PG8_STAGE(PG8_SB(1, 1), cB + hstep + kstep, voffB);
        PG8_WAIT_V(6); PG8_BAR;
    } else {
        PG8_STAGE(PG8_SB(0, 0), cB, voffB); PG8_STAGE(PG8_SA(0, 0), cA, voffA); PG8_STAGE(PG8_SB(0, 1), cB + hstep, voffB); PG8_STAGE(PG8_SA(0, 1), cA + hstep, voffA);
        pre();
        if (wr == 1) PG8_BAR;
        PG8_WAIT_V(4); PG8_BAR;
        PG8_STAGE(PG8_SB(1, 0), cB + kstep, voffB); PG8_STAGE(PG8_SA(1, 0), cA + kstep, voffA); PG8_STAGE(PG8_SB(1, 1), cB + hstep + kstep, voffB);
        PG8_WAIT_V(6); PG8_BAR;
    }
    for (;;) {
        const bool has_next = S.next(ui + 1, nxt);
        const char* nA = has_next ? g.a_ptr(nxt) : cA; const char* nB = has_next ? g.b_ptr(nxt) : cB;
        constexpr bool half = HF;
#pragma unroll 1
        for (int t = 0; t < nt; t += 2) {
            const bool last = (t == nt - 2);
            const char* a1 = cA + (size_t)(t + 1) * kstep;
            const char* a2 = last ? nA : cA + (size_t)(t + 2) * kstep; const char* b2 = last ? nB : cB + (size_t)(t + 2) * kstep;
            const char* a3 = a2 + kstep; const char* b3 = b2 + kstep;
            if (last && has_next) S.a_ready(nxt);
            if constexpr (SP2) {
            PG8_LDB(B0, 0, 0); PG8_LDB(B1, 0, 1); PG8_SCHED; PG8_LDA(At, 0, 0); PG8_STAGE(PG8_SA(1, 1), a1 + hstep, voffA);
            PG8_WAIT_V(8); PG8_WAIT_L(0); PG8_BAR; PG8_MMA(0, 0, At, B0); PG8_MMA(0, 1, At, B1); PG8_BAR; PG8_SCHED;
            if constexpr (!half) PG8_LDA(At, 0, 1); PG8_STAGE(PG8_SB(0, 0), b2, voffB); PG8_STAGE(PG8_SB(0, 1), b2 + hstep, voffB); PG8_STAGE(PG8_SA(0, 0), a2, voffA);
            PG8_WAIT_V(8); PG8_WAIT_L(0); PG8_BAR; if constexpr (!half) { PG8_MMA(1, 0, At, B0); PG8_MMA(1, 1, At, B1); } PG8_BAR; PG8_SCHED;
            PG8_LDB(B0, 1, 0); PG8_LDB(B1, 1, 1); PG8_SCHED; PG8_LDA(At, 1, 0); PG8_STAGE(PG8_SA(0, 1), a2 + hstep, voffA);
            PG8_WAIT_V(8); PG8_WAIT_L(0); PG8_BAR; PG8_MMA(0, 0, At, B0); PG8_MMA(0, 1, At, B1); PG8_BAR; PG8_SCHED;
            if constexpr (!half) PG8_LDA(At, 1, 1); PG8_STAGE(PG8_SB(1, 0), b3, voffB); PG8_STAGE(PG8_SB(1, 1), b3 + hstep, voffB); PG8_STAGE(PG8_SA(1, 0), a3, voffA);
            PG8_WAIT_V(8); PG8_WAIT_L(0); PG8_BAR; if constexpr (!half) { PG8_MMA(1, 0, At, B0); PG8_MMA(1, 1, At, B1); } PG8_BAR; PG8_SCHED;
            } else {
            PG8_LDB(B0, 0, 0); PG8_SCHED; PG8_LDA(At, 0, 0); PG8_STAGE(PG8_SA(1, 1), a1 + hstep, voffA);
            PG8_WAIT_L(8); PG8_BAR; PG8_WAIT_L(0); PG8_MMA(0, 0, At, B0); PG8_BAR; PG8_SCHED;
            PG8_LDB(B1, 0, 1); PG8_STAGE(PG8_SB(0, 0), b2, voffB);
            PG8_BAR; PG8_WAIT_L(0); PG8_MMA(0, 1, At, B1); PG8_BAR;
            PG8_LDA(At, 0, 1); PG8_STAGE(PG8_SA(0, 0), a2, voffA);
            PG8_BAR; PG8_WAIT_L(0); PG8_MMA(1, 0, At, B0); PG8_BAR; PG8_SCHED;
            PG8_STAGE(PG8_SB(0, 1), b2 + hstep, voffB);
            PG8_WAIT_V(6); PG8_BAR; PG8_MMA(1, 1, At, B1); PG8_BAR;
            PG8_LDB(B0, 1, 0); PG8_SCHED; PG8_LDA(At, 1, 0); PG8_STAGE(PG8_SA(0, 1), a2 + hstep, voffA);
            PG8_WAIT_L(8); PG8_BAR; PG8_WAIT_L(0); PG8_MMA(0, 0, At, B0); PG8_BAR; PG8_SCHED;
            PG8_LDB(B1, 1, 1); PG8_STAGE(PG8_SB(1, 0), b3, voffB);
            PG8_BAR; PG8_WAIT_L(0); PG8_MMA(0, 1, At, B1); PG8_BAR;
            PG8_LDA(At, 1, 1); PG8_STAGE(PG8_SA(1, 0), a3, voffA);
            PG8_BAR; PG8_WAIT_L(0); PG8_MMA(1, 0, At, B0); PG8_BAR; PG8_SCHED;
            PG8_STAGE(PG8_SB(1, 1), b3 + hstep, voffB);
            PG8_WAIT_V(6); PG8_BAR; PG8_MMA(1, 1, At, B1); PG8_BAR;
            }
        }
        if constexpr (ALIGN_EPI) { if (wr == 0) PG8_BAR; }
        if constexpr (F8) asm volatile("s_nop 15\n\ts_nop 15" ::: "memory");
        { int fr_ = fr, fq_ = fq; asm volatile("" : "+v"(fr_), "+v"(fq_));
          E(acc, cur, wr, wc, fr_, fq_);
#ifdef REP_EPI
          if constexpr (Epi::REP2) { asm volatile("" : "+v"(fr_), "+v"(fq_)); E(acc, cur, wr, wc, fr_, fq_); }
#endif
        } S.done(cur);
        if (!has_next) break;
        if (!E.keep(cur)) {
#pragma unroll
        for (int a = 0; a < 2; ++a)
#pragma unroll
            for (int b = 0; b < 2; ++b)
#pragma unroll
                for (int m = 0; m < 4; ++m)
#pragma unroll
                    for (int n = 0; n < 2; ++n) acc[a][b][m][n] = (f32x4){0.f, 0.f, 0.f, 0.f};
        }
        cur = nxt; cA = nA; cB = nB; ++ui;
        if constexpr (ALIGN_EPI) { if (wr == 1) PG8_BAR; }
    }
    PG8_WAIT_V(0);
    if constexpr (!ALIGN_EPI) { if (wr == 0) PG8_BAR; }
    PG8_BAR;
#undef PG8_SA
#undef PG8_SB
#undef PG8_STAGE
#undef PG8_LDA
#undef PG8_LDB
#undef PG8_MMA
#undef PG8_CAT8
#undef PG8_WAIT_V
#undef PG8_WAIT_L
#undef PG8_BAR
#undef PG8_SCHED
}
}

__device__ __forceinline__ void load_rstd(const float* ssq, int row0, int fq, float (&rs)[2][4]) {
#pragma unroll
    for (int ai = 0; ai < 2; ++ai)
#pragma unroll
        for (int m = 0; m < 4; ++m) {
            const f32x4 a = *(const f32x4*)(ssq + (size_t)(row0 + ai * 128 + m * 16) * 16 + fq * 4);
            float s = (a[0] + a[1]) + (a[2] + a[3]);
            s += __shfl_xor(s, 16); s += __shfl_xor(s, 32);
            rs[ai][m] = __builtin_amdgcn_rsqf(s * (1.0f / D) + EPS);
        }
    asm volatile("" : "+v"(rs[0][0]), "+v"(rs[0][1]), "+v"(rs[0][2]), "+v"(rs[0][3]), "+v"(rs[1][0]), "+v"(rs[1][1]), "+v"(rs[1][2]), "+v"(rs[1][3]));
}
__device__ __forceinline__ void load_rstd4(const float* ssq, int row0, int fq, float (&rs)[4]) {
#pragma unroll
    for (int m = 0; m < 4; ++m) {
        const f32x4 a = *(const f32x4*)(ssq + (size_t)(row0 + m * 16) * 16 + fq * 4);
        float s = (a[0] + a[1]) + (a[2] + a[3]);
        s += __shfl_xor(s, 16); s += __shfl_xor(s, 32);
        rs[m] = __builtin_amdgcn_rsqf(s * (1.0f / D) + EPS);
    }
}
__device__ __forceinline__ void lds_rstd4(const LAS float* rl, int row0, float (&rs)[4]) {
#pragma unroll
    for (int m = 0; m < 4; ++m) rs[m] = rl[(row0 + m * 16) & 2047];
}
__device__ __forceinline__ u32x4 pack8(const f32x4 v0, const f32x4 v1) { u32x4 w; w.x = cvt_pk_bf16(v0[0], v0[1]); w.y = cvt_pk_bf16(v0[2], v0[3]); w.z = cvt_pk_bf16(v1[0], v1[1]); w.w = cvt_pk_bf16(v1[2], v1[3]); return w; }

#ifndef NT_STORES
#define NT_STORES 0
#endif
#if NT_STORES
#define ST16(p, v) __builtin_nontemporal_store((v), (u32x4*)(p))
#else
#ifdef DUP_SAME
#define ST16(p, v) do { const u32x4 v_ = (v); *(volatile u32x4*)(p) = v_; *(volatile u32x4*)(p) = v_; } while (0)
#else
#define ST16(p, v) (*(u32x4*)(p) = (v))
#endif
#endif
__device__ __forceinline__ u32x4 dpp_swap1(const u32x4 v) { u32x4 r;
#pragma unroll
    for (int j = 0; j < 4; ++j) r[j] = (unsigned)__builtin_amdgcn_update_dpp(0, (int)v[j], 0xB1  , 0xf, 0xf, true);
    return r; }
__device__ __forceinline__ void store_pair(bf16_t* pe, bf16_t* po, const u32x4 A, const u32x4 B, bool odd) {
    const u32x4 Sx = odd ? A : B, R = dpp_swap1(Sx);
    const u32x4 d1 = odd ? R : A, d2 = odd ? B : R; const int co = odd ? 32 : 0;
    *(u32x4*)(pe + co) = d1; *(u32x4*)(po + co) = d2;
}

__device__ __forceinline__ void store_pair8(unsigned char* pe, unsigned char* po, const u32x2 A, const u32x2 B, bool odd) {
    const u32x2 Sx = odd ? A : B; u32x2 R;
    R.x = (unsigned)__builtin_amdgcn_update_dpp(0, (int)Sx.x, 0xB1, 0xf, 0xf, true); R.y = (unsigned)__builtin_amdgcn_update_dpp(0, (int)Sx.y, 0xB1, 0xf, 0xf, true);
    const u32x2 d1 = odd ? R : A, d2 = odd ? B : R; const int co = odd ? 32 : 0;
    *(u32x2*)(pe + co) = d1; *(u32x2*)(po + co) = d2;
}
__device__ __forceinline__ unsigned fp8x4(const f32x4 v) { int w = 0; w = __builtin_amdgcn_cvt_pk_fp8_f32(v[0], v[1], w, false); w = __builtin_amdgcn_cvt_pk_fp8_f32(v[2], v[3], w, true); return (unsigned)w; }
__device__ __forceinline__ unsigned q8x4(const f32x4 g) { unsigned w = 0; w = __builtin_amdgcn_cvt_pk_u8_f32(g[0] * 255.f, 0, w); w = __builtin_amdgcn_cvt_pk_u8_f32(g[1] * 255.f, 1, w); w = __builtin_amdgcn_cvt_pk_u8_f32(g[2] * 255.f, 2, w); w = __builtin_amdgcn_cvt_pk_u8_f32(g[3] * 255.f, 3, w); return w; }
__device__ __forceinline__ unsigned q8x4_raw(const f32x4 y) { unsigned w = 0; w = __builtin_amdgcn_cvt_pk_u8_f32(y[0], 0, w); w = __builtin_amdgcn_cvt_pk_u8_f32(y[1], 1, w); w = __builtin_amdgcn_cvt_pk_u8_f32(y[2], 2, w); w = __builtin_amdgcn_cvt_pk_u8_f32(y[3], 3, w); return w; }
__device__ __forceinline__ f32x4 dq8x4(unsigned w) { f32x4 g; g[0] = fmaxf((float)(w & 255u), 0.5f); g[1] = fmaxf((float)((w >> 8) & 255u), 0.5f); g[2] = fmaxf((float)((w >> 16) & 255u), 0.5f); g[3] = fmaxf((float)(w >> 24), 0.5f); return g * (1.0f / 255.0f); }

struct EpiIn {
    static constexpr bool PERM = true;
#ifdef REP_EPI
    static constexpr bool REP2 = (REP_EPI & 1) != 0;
#endif
    const LAS float* rl; const float* cs;
    bf16_t* seg; bf16_t* dil; unsigned char* gt;
    const LAS float* gw;
    __device__ __forceinline__ bool keep(const pg8::Unit&) const { return false; }
    template <int FN>
    __device__ __forceinline__ void rows(const f32x4 (&acc)[2][2][4][2], bf16_t* base  , size_t ldc, int row0, int sh, int wc, int fq, int nai) const {
        const bool odd = (row0 & 1) != 0;
#pragma unroll
        for (int ai = 0; ai < 2; ++ai) if (ai < nai) { float rs4[4]; lds_rstd4(rl, row0 + ai * 128, rs4);
#pragma unroll
            for (int m = 0; m < 4; ++m) {
                const int t = row0 + ai * 128 + m * 16, te = t & ~1, to = te + 1;
                const int tre = ((te & ((1 << sh) - 1)) << (14 - sh)) + (te >> sh), tro = ((to & ((1 << sh) - 1)) << (14 - sh)) + (to >> sh);
                const float r = rs4[m];
                u32x4 pk[2];
#pragma unroll
                for (int bj = 0; bj < 2; ++bj) {
                    f32x4 v0 = acc[ai][bj][m][0] * r, v1 = acc[ai][bj][m][1] * r;
                    if (FN <= 1) {
                        const f32x4* csp = (const f32x4*)(cs + ((size_t)t * 64 + (wc & 1) * 32 + bj * 16 + fq * 4) * 2); const f32x4 c01 = csp[0], c23 = csp[1];
                        const float ks = (FN == 1) ? 0.08838834764831845f : 1.0f;
                        f32x4 o0, o1;
                        o0[0] = (v0[0] * c01[0] - v0[1] * c01[1]) * ks; o0[1] = (v0[0] * c01[1] + v0[1] * c01[0]) * ks;
                        o0[2] = (v0[2] * c01[2] - v0[3] * c01[3]) * ks; o0[3] = (v0[2] * c01[3] + v0[3] * c01[2]) * ks;
                        o1[0] = (v1[0] * c23[0] - v1[1] * c23[1]) * ks; o1[1] = (v1[0] * c23[1] + v1[1] * c23[0]) * ks;
                        o1[2] = (v1[2] * c23[2] - v1[3] * c23[3]) * ks; o1[3] = (v1[2] * c23[3] + v1[3] * c23[2]) * ks;
                        v0 = o0; v1 = o1;
                    } else if (FN == 3) {
                        const float nr = r * -1.4426950408889634f; const f32x4 e0 = acc[ai][bj][m][0] * nr, e1 = acc[ai][bj][m][1] * nr;
#pragma unroll
                        for (int j = 0; j < 4; ++j) { v0[j] *= __builtin_amdgcn_rcpf(1.0f + __builtin_amdgcn_exp2f(e0[j])); v1[j] *= __builtin_amdgcn_rcpf(1.0f + __builtin_amdgcn_exp2f(e1[j])); }
                    } else if (FN == 4) {
                        constexpr float C0 = -2.0f * 0.7978845608028654f * 1.4426950408889634f, C1 = C0 * 0.044715f;
#pragma unroll
                        for (int j = 0; j < 4; ++j) {
                            v0[j] *= __builtin_amdgcn_rcpf(1.0f + __builtin_amdgcn_exp2f(v0[j] * fmaf(v0[j] * v0[j], C1, C0)));
                            v1[j] *= __builtin_amdgcn_rcpf(1.0f + __builtin_amdgcn_exp2f(v1[j] * fmaf(v1[j] * v1[j], C1, C0))); }
                    } else if (FN == 5) {
#pragma unroll
                        for (int j = 0; j < 4; ++j) { v0[j] = sigmoidf_(v0[j]); v1[j] = sigmoidf_(v1[j]); }
                    }
                    pk[bj] = pack8(v0, v1);
                }
                store_pair(base + (size_t)tre * ldc, base + (size_t)tro * ldc, pk[0], pk[1], odd);
            } }
    }
    __device__ __forceinline__ void rows_gate(const f32x4 (&acc)[2][2][4][2], unsigned char* base, int row0, int fq, int nai) const {
        const bool odd = (row0 & 1) != 0;
#pragma unroll
        for (int ai = 0; ai < 2; ++ai) if (ai < nai) { float rs4[4]; lds_rstd4(rl, row0 + ai * 128, rs4);
#pragma unroll
            for (int m = 0; m < 4; ++m) {
                const int t = row0 + ai * 128 + m * 16, te = t & ~1; const float nr = rs4[m] * -1.4426950408889634f;
                u32x2 pk[2];
#pragma unroll
                for (int bj = 0; bj < 2; ++bj) { f32x4 v0 = acc[ai][bj][m][0] * nr, v1 = acc[ai][bj][m][1] * nr;
#pragma unroll
                    for (int j = 0; j < 4; ++j) {
                        v0[j] = __builtin_amdgcn_rcpf(fmaf(__builtin_amdgcn_exp2f(v0[j]), 1.0f / 255.0f, 1.0f / 255.0f)); v1[j] = __builtin_amdgcn_rcpf(fmaf(__builtin_amdgcn_exp2f(v1[j]), 1.0f / 255.0f, 1.0f / 255.0f)); }
                    pk[bj].x = q8x4_raw(v0); pk[bj].y = q8x4_raw(v1); }
                store_pair8(base + (size_t)te * GT_LD, base + (size_t)(te + 1) * GT_LD, pk[0], pk[1], odd);
            } }
    }
    template <bool GAIN>
    __device__ __forceinline__ void rows_qk8(const f32x4 (&acc)[2][2][4][2], unsigned char* base  , float* nrm  , const LAS float* gwc  , int row0, int sh, int fq, int nai) const {
        const bool odd = (row0 & 1) != 0;
        f32x4 w[2][2];
#pragma unroll
        for (int bj = 0; bj < 2; ++bj)
#pragma unroll
            for (int n = 0; n < 2; ++n) { w[bj][n] = (f32x4){1.f, 1.f, 1.f, 1.f}; if (GAIN) w[bj][n] = *(const LAS f32x4*)(gwc + bj * 32 + n * 4); }
#pragma unroll
        for (int ai = 0; ai < 2; ++ai) if (ai < nai) { float rs4[4]; lds_rstd4(rl, row0 + ai * 128, rs4); float sv = 0.f;
#pragma unroll
            for (int m = 0; m < 4; ++m) {
                const int t = row0 + ai * 128 + m * 16, te = t & ~1, to = te + 1;
                const int tre = ((te & ((1 << sh) - 1)) << (14 - sh)) + (te >> sh), tro = ((to & ((1 << sh) - 1)) << (14 - sh)) + (to >> sh);
                const float r = rs4[m]; float ss = 0.f;
                u32x2 pk[2];
#pragma unroll
                for (int bj = 0; bj < 2; ++bj) {
                    f32x4 v0 = acc[ai][bj][m][0] * r, v1 = acc[ai][bj][m][1] * r;
                    ss += ((v0[0] * v0[0] + v0[1] * v0[1]) + (v0[2] * v0[2] + v0[3] * v0[3])) + ((v1[0] * v1[0] + v1[1] * v1[1]) + (v1[2] * v1[2] + v1[3] * v1[3]));
                    if (GAIN) { v0 = v0 * w[bj][0]; v1 = v1 * w[bj][1]; }
                    pk[bj].x = fp8x4(v0); pk[bj].y = fp8x4(v1);
                }
                ss = sum_fq(ss); sv = (fq == m) ? ss : sv;
                store_pair8(base + (size_t)tre * 128, base + (size_t)tro * 128, pk[0], pk[1], odd);
            }
            const int t = row0 + ai * 128 + fq * 16, tr = ((t & ((1 << sh) - 1)) << (14 - sh)) + (t >> sh);
            nrm[(size_t)tr * 2] = sv;
        }
    }
    __device__ __forceinline__ void operator()(f32x4 (&acc)[2][2][4][2], const pg8::Unit& u, int wr, int wc, int fr, int fq) const {
        const int row0 = u.pm * 256 + (u.hf == 2 ? 128 : 0) + wr * 64 + fr, pn = u.pn, cw = wc * 64 + fq * 8, nai = u.hf ? 1 : 2;
        if (pn < 12) {
            const int sg = pn >> 1;
            bf16_t* base = seg + (size_t)sg * S * 512 + (pn & 1) * 256 + cw;
            if (sg == 0) rows<0>(acc, base, 512, row0, 0, wc, fq, nai);
            else if (sg == 1) rows<1>(acc, base, 512, row0, 0, wc, fq, nai);
            else if (sg == 2) rows<2>(acc, base, 512, row0, 0, wc, fq, nai);
            else if (sg == 3) rows<3>(acc, base, 512, row0, 0, wc, fq, nai);
            else rows<4>(acc, base, 512, row0, 0, wc, fq, nai);
        } else if (pn < 30) {
            const int q = pn - 12, which = q / 6, r6 = q - which * 6, g = r6 >> 1, hd = (r6 & 1) * 2 + (wc >> 1);
            bf16_t* base = dil + ((size_t)which * 12 + (size_t)g * 4 + hd) * S * 128 + (cw & 127);
            if (which == 2) rows<2>(acc, base, 128, row0, 2 * g, wc, fq, nai);
            else {
                unsigned char* b8 = (unsigned char*)(dil + (size_t)which * 12 * S * 128) + ((size_t)g * 4 + hd) * S * 128 + (cw & 127);
                float* nrm = (float*)((unsigned char*)(dil + (size_t)which * 12 * S * 128) + DIL_NRM_OFF) + ((size_t)g * 4 + hd) * S * 2 + (wc & 1);
                const LAS float* gwc = gw + (cw & 127);
                if (which == 0) rows_qk8<true>(acc, b8, nrm, gwc, row0, 2 * g, fq, nai); else rows_qk8<false>(acc, b8, nrm, gwc, row0, 2 * g, fq, nai);
            }
        } else {
            rows_gate(acc, gt + (size_t)(pn - 30) * 256 + cw, row0, fq, nai);
        }
    }
};

struct EpiMerge {
    static constexpr bool PERM = true;
#ifdef REP_EPI
    static constexpr bool REP2 = false;
#endif
    const unsigned char* gt; bf16_t* out;
    __device__ __forceinline__ bool keep(const pg8::Unit& u) const { return u.pb < 2; }
    static __device__ __forceinline__ f32x4 lv4(unsigned w) { f32x4 g; g[0] = fmaxf((float)(w & 255u), 0.5f); g[1] = fmaxf((float)((w >> 8) & 255u), 0.5f); g[2] = fmaxf((float)((w >> 16) & 255u), 0.5f); g[3] = fmaxf((float)(w >> 24), 0.5f); return g; }
    __device__ __forceinline__ void operator()(f32x4 (&acc)[2][2][4][2], const pg8::Unit& u, int wr, int wc, int fr, int fq) const {
        const int row0 = u.pm * 256 + wr * 64 + fr, col0 = u.pn * 256 + wc * 32 + fq * 8, pb = u.pb;
        if (pb < 2) {
            u32x2 ga[2][4][2], gb[2][4][2];
#pragma unroll
            for (int ai = 0; ai < 2; ++ai)
#pragma unroll
                for (int m = 0; m < 4; ++m)
#pragma unroll
                    for (int bj = 0; bj < 2; ++bj) { const unsigned char* gp = gt + (size_t)(row0 + ai * 128 + m * 16) * GT_LD + pb * 1024 + col0 + bj * 128;
                        ga[ai][m][bj] = *(const u32x2*)gp; gb[ai][m][bj] = *(const u32x2*)(gp + 1024); }
#pragma unroll
            for (int ai = 0; ai < 2; ++ai)
#pragma unroll
                for (int m = 0; m < 4; ++m)
#pragma unroll
                    for (int bj = 0; bj < 2; ++bj) {
                        f32x4 fa = lv4(ga[ai][m][bj].x), fb = lv4(ga[ai][m][bj].y); const f32x4 da = lv4(gb[ai][m][bj].x), db = lv4(gb[ai][m][bj].y);
#pragma unroll
                        for (int j = 0; j < 4; ++j) { fa[j] *= __builtin_amdgcn_rcpf(da[j]); fb[j] *= __builtin_amdgcn_rcpf(db[j]); }
                        acc[ai][bj][m][0] = acc[ai][bj][m][0] * fa; acc[ai][bj][m][1] = acc[ai][bj][m][1] * fb;
                    }
        } else {
            u32x2 ga[2][4][2];
#pragma unroll
            for (int ai = 0; ai < 2; ++ai)
#pragma unroll
                for (int m = 0; m < 4; ++m)
#pragma unroll
                    for (int bj = 0; bj < 2; ++bj) ga[ai][m][bj] = *(const u32x2*)(gt + (size_t)(row0 + ai * 128 + m * 16) * GT_LD + pb * 1024 + col0 + bj * 128);
#pragma unroll
            for (int ai = 0; ai < 2; ++ai)
#pragma unroll
                for (int m = 0; m < 4; ++m)
#pragma unroll
                    for (int bj = 0; bj < 2; ++bj) {
                        const f32x4 fa = lv4(ga[ai][m][bj].x) * (1.0f / 255.0f), fb = lv4(ga[ai][m][bj].y) * (1.0f / 255.0f);
                        *(u32x4*)(out + (size_t)(row0 + ai * 128 + m * 16) * 1024 + col0 + bj * 128) = pack8(acc[ai][bj][m][0] * fa, acc[ai][bj][m][1] * fb);
                    }
        }
    }
};

struct EpiRes {
    static constexpr bool PERM = true;
#ifdef REP_EPI
    static constexpr bool REP2 = false;
#endif
    const float* xin32; float* xout32; bf16_t* xb; float* ssq; unsigned char* xb8;
    __device__ __forceinline__ bool keep(const pg8::Unit&) const { return false; }
    __device__ __forceinline__ void finish(const f32x4 x0, const f32x4 x1, size_t off, float& q) const {
        if (xout32) { *(f32x4*)(xout32 + off) = x0; *(f32x4*)(xout32 + off + 4) = x1; }
        else { *(u32x4*)(xb + off) = pack8(x0, x1); if (xb8) { u32x2 w8; w8.x = fp8x4(x0); w8.y = fp8x4(x1); *(u32x2*)(xb8 + off) = w8; } }
        q += ((x0[0] * x0[0] + x0[1] * x0[1]) + (x0[2] * x0[2] + x0[3] * x0[3])) + ((x1[0] * x1[0] + x1[1] * x1[1]) + (x1[2] * x1[2] + x1[3] * x1[3]));
    }
    __device__ __forceinline__ void operator()(f32x4 (&acc)[2][2][4][2], const pg8::Unit& u, int wr, int wc, int fr, int fq) const {
        const int row0 = u.pm * 256 + wr * 64 + fr, col0 = u.pn * 256 + wc * 32 + fq * 8;
        if (!xin32) {
            u32x4 xw[8][2];
#define RES_LD(g_) do { _Pragma("unroll") for (int bj = 0; bj < 2; ++bj) xw[g_][bj] = *(const u32x4*)(xb + (size_t)(row0 + ((g_) >> 2) * 128 + ((g_) & 3) * 16) * D + col0 + bj * 128); } while (0)
            RES_LD(0); RES_LD(1); RES_LD(2); RES_LD(3); RES_LD(4); RES_LD(5);
#pragma unroll
            for (int g = 0; g < 8; ++g) {
                const int ai = g >> 2, m = g & 3, t = row0 + ai * 128 + m * 16; const size_t off = (size_t)t * D + col0;
                float q = 0.f;
#pragma unroll
                for (int bj = 0; bj < 2; ++bj) {
                    const u32x4 w = xw[g][bj];
                    const f32x4 x0 = (f32x4){bf_lo(w[0]), bf_hi(w[0]), bf_lo(w[1]), bf_hi(w[1])} + acc[ai][bj][m][0], x1 = (f32x4){bf_lo(w[2]), bf_hi(w[2]), bf_lo(w[3]), bf_hi(w[3])} + acc[ai][bj][m][1];
                    finish(x0, x1, off + bj * 128, q);
                }
                q = sum_fq(q);
                if (fq == 0 && !xout32) ssq[(size_t)t * 16 + u.pn * 4 + wc] = q;
                asm volatile("" ::: "memory");
                if (g == 0) RES_LD(6);
                if (g == 1) RES_LD(7);
            }
#undef RES_LD
            return;
        }
#pragma unroll
        for (int ai = 0; ai < 2; ++ai)
#pragma unroll
            for (int m = 0; m < 4; ++m) {
                const int t = row0 + ai * 128 + m * 16; const size_t off = (size_t)t * D + col0;
                float q = 0.f;
#pragma unroll
                for (int bj = 0; bj < 2; ++bj) {
                    const f32x4 x0 = *(const f32x4*)(xin32 + off + bj * 128) + acc[ai][bj][m][0], x1 = *(const f32x4*)(xin32 + off + bj * 128 + 4) + acc[ai][bj][m][1];
                    finish(x0, x1, off + bj * 128, q);
                }
                q = sum_fq(q);
                if (fq == 0 && !xout32) ssq[(size_t)t * 16 + u.pn * 4 + wc] = q;
                if (m & 1) asm volatile("" ::: "memory");
            }
    }
};

struct EpiGU {
    static constexpr bool PERM = true;
#ifdef REP_EPI
    static constexpr bool REP2 = (REP_EPI & 2) != 0;
#endif
    const LAS float* rl; bf16_t* act;
    __device__ __forceinline__ bool keep(const pg8::Unit&) const { return false; }
    __device__ __forceinline__ void operator()(f32x4 (&acc)[2][2][4][2], const pg8::Unit& u, int wr, int wc, int fr, int fq) const {
        const int row0 = u.pm * 256 + (u.hf == 2 ? 128 : 0) + wr * 64 + fr, col0 = u.pn * 128 + wc * 32 + fq * 8, nai = u.hf ? 1 : 2;
#pragma unroll
        for (int ai = 0; ai < 2; ++ai) if (ai < nai) { float rs4[4]; lds_rstd4(rl, row0 + ai * 128, rs4);
#pragma unroll
            for (int m = 0; m < 4; ++m) {
                const int t = row0 + ai * 128 + m * 16; const float r = rs4[m], nr = r * -1.4426950408889634f, r2 = r * r;
                const f32x4 e0 = acc[ai][0][m][0] * nr, e1 = acc[ai][0][m][1] * nr; f32x4 g0 = acc[ai][0][m][0] * acc[ai][1][m][0], g1 = acc[ai][0][m][1] * acc[ai][1][m][1];
#pragma unroll
                for (int j = 0; j < 4; ++j) { g0[j] *= r2 * __builtin_amdgcn_rcpf(1.0f + __builtin_amdgcn_exp2f(e0[j])); g1[j] *= r2 * __builtin_amdgcn_rcpf(1.0f + __builtin_amdgcn_exp2f(e1[j])); }
                *(u32x4*)(act + (size_t)t * DFF + col0) = pack8(g0, g1);
            } }
    }
};

#ifdef PROBE_KLOOP
struct EpiNull {
    static constexpr bool PERM = true;
#ifdef REP_EPI
    static constexpr bool REP2 = false;
#endif
    __device__ __forceinline__ bool keep(const pg8::Unit&) const { return false; }
    __device__ __forceinline__ void operator()(f32x4 (&acc)[2][2][4][2], const pg8::Unit&, int, int, int, int) const {
#pragma unroll
        for (int a = 0; a < 2; ++a)
#pragma unroll
            for (int b = 0; b < 2; ++b)
#pragma unroll
                for (int m = 0; m < 4; ++m)
#pragma unroll
                    for (int n = 0; n < 2; ++n) asm volatile("" :: "v"(acc[a][b][m][n]));
    }
};
#endif

typedef GAS unsigned gu32;
#define RLX_AGENT __ATOMIC_RELAXED, __HIP_MEMORY_SCOPE_AGENT
struct Frame {
    LAS unsigned char* lds;
    int tid, G, bid;
    unsigned char* ws;
};
enum { IN_X = 0, IN_GMIX, IN_WIN, IN_RETG, IN_SGLNG, IN_SGLNB, IN_SGW, IN_SGB, IN_DILQG, IN_DILKG, IN_WBR, IN_WO, IN_GFFN, IN_WGU, IN_WD, IN_OUT };
__device__ __forceinline__ const float* inp(const Frame& F, int i) { int off = MISC_OFF + 64 + 8 * i; asm volatile("" : "+s"(off));
    const unsigned long long v = *(const LAS unsigned long long*)(F.lds + off); return (const float*)(const GAS float*)v; }
__device__ __forceinline__ const float* uni_ptr(const float* p) { const unsigned long long v = (unsigned long long)p; const unsigned lo = __builtin_amdgcn_readfirstlane((unsigned)v), hi = __builtin_amdgcn_readfirstlane((unsigned)(v >> 32)); return (const float*)(const GAS float*)(((unsigned long long)hi << 32) | lo); }
#define PHASE_IDS() int tid = F.tid; asm volatile("" : "+v"(tid)); const int bid = F.bid; (void)bid; const int lane = tid & 63, wave = __builtin_amdgcn_readfirstlane(tid >> 6); (void)lane; (void)wave
#define MFMA16(a, b, c) __builtin_amdgcn_mfma_f32_16x16x32_bf16((a), (b), (c), 0, 0, 0)
#define MFMA32(a, b, c) __builtin_amdgcn_mfma_f32_32x32x16_bf16((a), (b), (c), 0, 0, 0)
constexpr int MP = 272;

__device__ __forceinline__ int prow(int c) { return (c & ~31) + (((c >> 2) & 1) << 4) + (((c >> 3) & 3) << 2) + (c & 3); }
__device__ __forceinline__ float ret_log2_gamma(int h) { return log2f(1.0f - __builtin_amdgcn_exp2f((float)(-5 - h))); }

__device__ __forceinline__ int wave_cols(int n) { const int r = n & 255; return (n & ~255) + 64 * ((r >> 5) & 3) + 32 * (r >> 7) + (r & 31); }
__device__ __forceinline__ int src_col(int map, int n) {
    if (map == 1) {
        n = wave_cols(n);
        if (n < 1024) { const int p = n & 127; return (n & ~127) + (p >> 1) + 64 * (p & 1); }
        return n;
    }
    if (map == 2) { const int pn = n >> 8, j = n & 255; return (j < 128) ? (128 * pn + j) : (DFF + 128 * pn + (j - 128)); }
    return n;
}
struct P0Item { const float* W; bf16_t* WT; const float* ks; int K, N, map, idx; };
constexpr int P0_I_IN = (D / 64) * (NIN / 32), P0_I_B = (512 / 64) * (D / 32), P0_I_O = (D / 64) * (D / 32), P0_I_GU = (D / 64) * (NGU / 32), P0_I_D = (DFF / 64) * (D / 32);
constexpr int P0_I_LAYER = P0_I_IN + 3 * P0_I_B + P0_I_O + P0_I_GU + P0_I_D;
__device__ __forceinline__ P0Item p0_decode(const Frame& F, int it) {
    const int l = it / P0_I_LAYER; int r = it - l * P0_I_LAYER;
    unsigned char* wl = F.ws + WS_W + (size_t)l * W_LAYER_B;
    P0Item a;
    if (r < P0_I_IN) { a.W = inp(F, IN_WIN) + (size_t)l * D * NIN; a.K = D; a.N = NIN; a.WT = (bf16_t*)(wl + WOFF_IN); a.ks = inp(F, IN_GMIX) + l * D; a.map = 1; a.idx = r; return a; } r -= P0_I_IN;
    if (r < 3 * P0_I_B) { const int b = r / P0_I_B; a.W = inp(F, IN_WBR) + ((size_t)l * 3 + b) * 512 * D; a.K = 512; a.N = D; a.WT = (bf16_t*)(wl + WOFF_B) + (size_t)b * D * 512; a.ks = nullptr; a.map = 0; a.idx = r - b * P0_I_B; return a; } r -= 3 * P0_I_B;
    if (r < P0_I_O) { a.W = inp(F, IN_WO) + (size_t)l * D * D; a.K = D; a.N = D; a.WT = (bf16_t*)(wl + WOFF_O); a.ks = nullptr; a.map = 0; a.idx = r; return a; } r -= P0_I_O;
    if (r < P0_I_GU) { a.W = inp(F, IN_WGU) + (size_t)l * D * NGU; a.K = D; a.N = NGU; a.WT = (bf16_t*)(wl + WOFF_GU); a.ks = inp(F, IN_GFFN) + l * D; a.map = 2; a.idx = r; return a; } r -= P0_I_GU;
    a.W = inp(F, IN_WD) + (size_t)l * DFF * D; a.K = DFF; a.N = D; a.WT = (bf16_t*)(wl + WOFF_D); a.ks = nullptr; a.map = 0; a.idx = r; return a;
}
__device__ __forceinline__ void p0_item_load(const P0Item& a, float (&wv)[32], f32x4 (&sc)[2], int lane) {
    const int nblk = a.N / 32, kb = a.idx / nblk, nb = a.idx - kb * nblk, k0 = 64 * kb, n0 = 32 * nb;
    const int sn = src_col(a.map, n0 + (lane & 31));
#pragma unroll
    for (int i = 0; i < 32; ++i) wv[i] = a.W[(size_t)(k0 + 2 * i + (lane >> 5)) * a.N + sn];
    if (a.ks) { sc[0] = *(const f32x4*)(a.ks + k0 + 8 * (lane & 7)); sc[1] = *(const f32x4*)(a.ks + k0 + 8 * (lane & 7) + 4); }
    else { sc[0] = (f32x4){1.f, 1.f, 1.f, 1.f}; sc[1] = sc[0]; }
}
__device__ __forceinline__ void p0_item_store(const P0Item& a, const float (&wv)[32], const f32x4 (&sc)[2], LAS float* scr, int lane) {
    const int nblk = a.N / 32, kb = a.idx / nblk, nb = a.idx - kb * nblk, k0 = 64 * kb, n0 = 32 * nb;
#pragma unroll
    for (int i = 0; i < 32; ++i) scr[(2 * i + (lane >> 5)) * 33 + (lane & 31)] = wv[i];
    LDS_WAIT(); asm volatile("" ::: "memory");
    const int c = lane & 7;
#if F8_TILES == 6
    const int pnt = n0 >> 8; const bool f8 = a.map == 1 && pnt >= 12; const int lt8 = pnt - 12;
#elif F8_TILES == 5
    const int pnt = n0 >> 8; const bool f8 = a.map == 1 && ((pnt >= 12 && pnt < 30) || pnt >= 38); const int lt8 = pnt < 30 ? pnt - 12 : pnt - 20;
#elif F8_TILES == 4
    const int pnt = n0 >> 8; const bool f8 = a.map == 1 && (pnt < 6 || (pnt >= 12 && pnt < 30)); const int lt8 = pnt < 6 ? pnt : pnt - 6;
#else
    const int pnt = n0 >> 8; const bool f8 = a.map == 1 && ((((F8_TILES) & 1) && pnt >= 12 && pnt < 24) || (((F8_TILES) & 2) && pnt >= 30)); const int lt8 = pnt < 24 ? pnt - 12 : pnt - 18;
#endif
    const bool f8b = a.map == 3;
    if (f8 || f8b) {
        const size_t pitch = f8b ? (size_t)a.K * 2 : (size_t)a.K;
        unsigned char* w8 = f8b ? (unsigned char*)a.WT + (size_t)n0 * pitch + k0 + 8 * c
                                : (unsigned char*)a.WT + (WOFF_IN8 - WOFF_IN) + ((size_t)(lt8 * 256 + (n0 & 255))) * pitch + k0 + 8 * c;
#pragma unroll
        for (int j = 0; j < 4; ++j) { const int n = (lane >> 3) + 8 * j; const LAS float* s = scr + (8 * c) * 33 + n;
            u32x2 o; o.x = fp8x4((f32x4){s[0 * 33] * sc[0][0], s[1 * 33] * sc[0][1], s[2 * 33] * sc[0][2], s[3 * 33] * sc[0][3]});
            o.y = fp8x4((f32x4){s[4 * 33] * sc[1][0], s[5 * 33] * sc[1][1], s[6 * 33] * sc[1][2], s[7 * 33] * sc[1][3]});
            *(u32x2*)(w8 + (size_t)n * pitch) = o; }
    } else {
#pragma unroll
    for (int j = 0; j < 4; ++j) { const int n = (lane >> 3) + 8 * j; const LAS float* s = scr + (8 * c) * 33 + n;
        u32x4 o; o.x = cvt_pk_bf16(s[0 * 33] * sc[0][0], s[1 * 33] * sc[0][1]); o.y = cvt_pk_bf16(s[2 * 33] * sc[0][2], s[3 * 33] * sc[0][3]);
        o.z = cvt_pk_bf16(s[4 * 33] * sc[1][0], s[5 * 33] * sc[1][1]); o.w = cvt_pk_bf16(s[6 * 33] * sc[1][2], s[7 * 33] * sc[1][3]);
        *(u32x4*)(a.WT + (size_t)(n0 + n) * a.K + k0 + 8 * c) = o; }
    }
    LDS_WAIT(); asm volatile("" ::: "memory");
}
__device__ __forceinline__ void p0_items(Frame& F, int it0, int it1, int gw, int NGW) {
    PHASE_IDS();
    LAS float* scr = (LAS float*)(F.lds + wave * 16384);
    if (it0 + gw < it1) {
        int it = it0 + gw; P0Item a = p0_decode(F, it), b = a; float wa[32], wb[32]; f32x4 sa[2], sb[2];
        p0_item_load(a, wa, sa, lane);
        for (;;) {
            const int n1 = it + NGW; const bool h1 = n1 < it1;
            if (h1) { b = p0_decode(F, n1); p0_item_load(b, wb, sb, lane); }
            p0_item_store(a, wa, sa, scr, lane);
            if (!h1) break;
            const int n2 = n1 + NGW; const bool h2 = n2 < it1;
            if (h2) { a = p0_decode(F, n2); p0_item_load(a, wa, sa, lane); }
            p0_item_store(b, wb, sb, scr, lane);
            if (!h2) break;
            it = n2;
        }
    }
}
__device__ __forceinline__ void p0_side(Frame& F, int layer, int part, int nwg) {
    const int first = nwg % F.G, nside = F.G - first;
    if (F.bid < first) return;
    const int wave = __builtin_amdgcn_readfirstlane(F.tid >> 6);
    const int it0 = layer * P0_I_LAYER + (part == 0 ? P0_I_IN : P0_I_LAYER - P0_I_D);
    const int it1 = part == 0 ? layer * P0_I_LAYER + P0_I_LAYER - P0_I_D : (layer + 1 < DEPTH ? (layer + 1) * P0_I_LAYER + P0_I_IN : DEPTH * P0_I_LAYER);
    p0_items(F, it0, it1, (F.bid - first) * NWAVES + wave, nside * NWAVES);
}
__device__ __forceinline__ void p0_prologue(Frame& F) {
    PHASE_IDS();
    const int gw = bid * NWAVES + wave, NGW = F.G * NWAVES;
    p0_items(F, 0, P0_I_IN, gw, NGW);
    const int gt = bid * NTHREADS + tid, NGT = F.G * NTHREADS;
    for (int i = gt; i < DEPTH * 4 * 128 * 128; i += NGT) {
        const int l = i >> 16, r = i & 65535, n = (r >> 7) & 127, m = r & 127;
        const float w = (m <= n) ? inp(F, IN_SGW)[i] : 0.f;
        ((bf16_t*)(F.ws + WS_W + (size_t)l * W_LAYER_B + WOFF_SG))[r] = f2bf(w);
    }
    double inv = 1.0;
    { const double rr = 0.86596432336006535;
      const int fi = gt & 63; for (int j = 0; j < fi; ++j) inv *= rr; }
    for (int i = gt; i < S * 64; i += NGT) {
        const int pos = i >> 6;
        const double a = (double)pos * inv;
        const double kq = __builtin_rint(a * 0.63661977236758134);
        double r = __builtin_fma(-kq, 1.5707963267948966, a); r = __builtin_fma(-kq, 6.123233995736766e-17, r);
        const double r2 = r * r;
        const double sn = r * (1.0 + r2 * (-1.0 / 6 + r2 * (1.0 / 120 + r2 * (-1.0 / 5040 + r2 * (1.0 / 362880 + r2 * (-1.0 / 39916800 + r2 * (1.0 / 6227020800.0)))))));
        const double cn = 1.0 + r2 * (-0.5 + r2 * (1.0 / 24 + r2 * (-1.0 / 720 + r2 * (1.0 / 40320 + r2 * (-1.0 / 3628800 + r2 * (1.0 / 479001600.0 + r2 * (-1.0 / 87178291200.0)))))));
        const int q = (int)((long long)kq & 3);
        const double c = (q == 0) ? cn : (q == 1) ? -sn : (q == 2) ? -cn : sn;
        const double s = (q == 0) ? sn : (q == 1) ? cn : (q == 2) ? -sn : -cn;
        ((f32x2*)(F.ws + WS_CS))[i] = (f32x2){(float)c, (float)s};
    }
    float* ssq = (float*)(F.ws + WS_SSQ);
    bf16_t* xb = (bf16_t*)(F.ws + WS_XB);
    const float* xin = inp(F, IN_X);
    for (int m = gw; m < S; m += 2 * NGW) {
        const int mb = (m + NGW < S) ? m + NGW : m;
        const f32x4* xa = (const f32x4*)(xin + (size_t)m * D) + lane; const f32x4* xc = (const f32x4*)(xin + (size_t)mb * D) + lane;
        f32x4 va[4], vc[4];
#pragma unroll
        for (int j = 0; j < 4; ++j) { va[j] = xa[64 * j]; vc[j] = xc[64 * j]; }
#pragma unroll
        for (int half = 0; half < 2; ++half) {
            const int mr = half ? mb : m; if (half && mb == m) break;
            u32x2* o8 = (u32x2*)(xb + (size_t)mr * D) + lane;
            unsigned* q8 = (unsigned*)(F.ws + WS_XB8 + (size_t)mr * D) + lane;
            float s = 0.f;
#pragma unroll
            for (int j = 0; j < 4; ++j) { const f32x4 v = half ? vc[j] : va[j]; s += (v[0] * v[0] + v[1] * v[1]) + (v[2] * v[2] + v[3] * v[3]); u32x2 w; w.x = cvt_pk_bf16(v[0], v[1]); w.y = cvt_pk_bf16(v[2], v[3]); o8[64 * j] = w; q8[64 * j] = fp8x4(v); }
#pragma unroll
            for (int o = 1; o < 64; o <<= 1) s += __shfl_xor(s, o);
            if (lane < 16) ssq[(size_t)mr * 16 + lane] = (lane == 0) ? s : 0.f;
        }
    }
}

__device__ __forceinline__ void ret_kv_units(Frame& F, int u0, int ustep) {
    PHASE_IDS();
    LAS unsigned char* Vt = F.lds; LAS unsigned char* Kt = F.lds + 128 * MP;
    const bf16_t* KR = (const bf16_t*)(F.ws + WS_SEG) + (size_t)1 * S * 512; const bf16_t* VR = (const bf16_t*)(F.ws + WS_SEG) + (size_t)2 * S * 512;
    if (u0 >= 512) return;
    u32x4 vv[4], kk[4];
#define KV_LOAD(u_) do { const size_t b_ = (size_t)((u_) >> 2) * 128 * 512 + ((u_) & 3) * 128; _Pragma("unroll") for (int i = 0; i < 4; ++i) { const int ch = tid + 512 * i, row = ch >> 4, cc = ch & 15; \
        vv[i] = *(const u32x4*)(VR + b_ + (size_t)row * 512 + cc * 8); kk[i] = *(const u32x4*)(KR + b_ + (size_t)row * 512 + cc * 8); } } while (0)
    KV_LOAD(u0);
    for (int u = u0; u < 512; u += ustep) {
        const int c = u >> 2, h = u & 3; const float lg2 = ret_log2_gamma(h);
#pragma unroll
        for (int i = 0; i < 4; ++i) {
            const int ch = tid + 512 * i, row = ch >> 4, cc = ch & 15;
            const float z = __builtin_amdgcn_exp2f((float)(127 - row) * lg2);
#pragma unroll
            for (int j = 0; j < 4; ++j) {
                *(LAS bf16_t*)(Vt + (cc * 8 + 2 * j) * MP + row * 2) = (bf16_t)(vv[i][j] & 0xffffu);
                *(LAS bf16_t*)(Vt + (cc * 8 + 2 * j + 1) * MP + row * 2) = (bf16_t)(vv[i][j] >> 16);
                const unsigned kz = cvt_pk_bf16(bf_lo(kk[i][j]) * z, bf_hi(kk[i][j]) * z);
                *(LAS bf16_t*)(Kt + (cc * 8 + 2 * j) * MP + row * 2) = (bf16_t)(kz & 0xffffu);
                *(LAS bf16_t*)(Kt + (cc * 8 + 2 * j + 1) * MP + row * 2) = (bf16_t)(kz >> 16);
            }
        }
        __syncthreads();
        { const int un = (u + ustep < 512) ? u + ustep : u; KV_LOAD(un); }
        const int fr = lane & 15, fq = lane >> 4;
        bf16x8 a[4];
#pragma unroll
        for (int ks = 0; ks < 4; ++ks) a[ks] = *(const LAS bf16x8*)(Vt + (wave * 16 + fr) * MP + ks * 64 + fq * 16);
        bf16_t* kvt = (bf16_t*)(F.ws + WS_KVT) + ((size_t)(c * 4 + h) * 128) * 128;
#pragma unroll
        for (int ct = 0; ct < 8; ++ct) {
            f32x4 acc = {0.f, 0.f, 0.f, 0.f};
#pragma unroll
            for (int ks = 0; ks < 4; ++ks) { const bf16x8 b = *(const LAS bf16x8*)(Kt + (ct * 16 + fr) * MP + ks * 64 + fq * 16); acc = MFMA16(b, a[ks], acc); }
            { u32x2 w; w.x = cvt_pk_bf16(acc[0], acc[1]); w.y = cvt_pk_bf16(acc[2], acc[3]); *(u32x2*)(kvt + (size_t)(wave * 16 + fr) * 128 + ct * 16 + fq * 4) = w; }
        }
        __syncthreads();
    }
#undef KV_LOAD
}

__device__ __forceinline__ void ret_scan(Frame& F) {
    PHASE_IDS();
    for (int p0 = bid * 128 + tid; p0 < 32768; p0 += F.G * 128) {
        const int h = p0 >> 13, idx = p0 & 8191;
        const float gc = __builtin_amdgcn_exp2f(128.0f * ret_log2_gamma(h));
        const unsigned* kv = (const unsigned*)(F.ws + WS_KVT) + (size_t)h * 8192 + idx;
        unsigned* rp = (unsigned*)(F.ws + WS_RP) + (size_t)h * 8192 + idx;
        float R0 = 0.f, R1 = 0.f;
        for (int c0 = 0; c0 < 128; c0 += 64) {
            unsigned v[64];
#pragma unroll
            for (int j = 0; j < 64; ++j) v[j] = kv[(size_t)(c0 + j) * 32768];
#pragma unroll
            for (int j = 0; j < 64; ++j) { rp[(size_t)(c0 + j) * 32768] = cvt_pk_bf16(R0, R1); R0 = R0 * gc + bf_lo(v[j]); R1 = R1 * gc + bf_hi(v[j]); }
        }
    }
}

struct RoRegs { u32x4 kk[4], vv[4], rv[4]; bf16x8 aq[4]; };
__device__ __forceinline__ void ro_load(Frame& F, int u, RoRegs& R) {
    PHASE_IDS(); const int fr = lane & 15, fq = lane >> 4;
    const bf16_t* SEG = (const bf16_t*)(F.ws + WS_SEG);
    const bf16_t* QR = SEG, *KR = SEG + (size_t)1 * S * 512, *VR = SEG + (size_t)2 * S * 512;
    const size_t b = (size_t)(u >> 2) * 128 * 512 + (u & 3) * 128; const bf16_t* RP = (const bf16_t*)(F.ws + WS_RP) + (size_t)u * 16384;
#pragma unroll
    for (int i = 0; i < 4; ++i) { const int ch = tid + 512 * i, row = ch >> 4, cc = ch & 15;
        R.kk[i] = *(const u32x4*)(KR + b + (size_t)row * 512 + cc * 8); R.vv[i] = *(const u32x4*)(VR + b + (size_t)row * 512 + cc * 8); R.rv[i] = *(const u32x4*)(RP + (size_t)row * 128 + cc * 8); }
#pragma unroll
    for (int ks = 0; ks < 4; ++ks) R.aq[ks] = *(const bf16x8*)(QR + b + (size_t)(wave * 16 + fr) * 512 + ks * 32 + fq * 8);
}
__device__ __forceinline__ void ro_unit(Frame& F, int layer, int u, const RoRegs& R, int un, RoRegs* nxt) {
    PHASE_IDS(); const int fr = lane & 15, fq = lane >> 4;
    LAS unsigned char* Kl = F.lds; LAS unsigned char* Vt = F.lds + 128 * MP; LAS unsigned char* Rl = F.lds + 2 * 128 * MP; LAS unsigned char* Sl = F.lds + 3 * 128 * MP;
    const bf16_t* GR = (const bf16_t*)(F.ws + WS_SEG) + (size_t)3 * S * 512;
    bf16_t* YA = (bf16_t*)(F.ws + WS_YA);
    const int c = u >> 2, h = u & 3, t0 = c * 128; const float lg2 = ret_log2_gamma(h);
#pragma unroll
    for (int i = 0; i < 4; ++i) {
        const int ch = tid + 512 * i, row = ch >> 4, cc = ch & 15;
        *(LAS u32x4*)(Kl + row * MP + cc * 16) = R.kk[i];
        *(LAS u32x4*)(Rl + prow(row) * MP + cc * 16) = R.rv[i];
#pragma unroll
        for (int j = 0; j < 4; ++j) {
            *(LAS bf16_t*)(Vt + prow(cc * 8 + 2 * j) * MP + row * 2) = (bf16_t)(R.vv[i][j] & 0xffffu);
            *(LAS bf16_t*)(Vt + prow(cc * 8 + 2 * j + 1) * MP + row * 2) = (bf16_t)(R.vv[i][j] >> 16);
        }
    }
    const float* rg = inp(F, IN_RETG) + layer * 512 + h * 128;
    const size_t rowoff = (size_t)(t0 + wave * 16 + fr) * 512 + h * 128;
    u32x4 grv[4]; f32x4 g0v[4], g1v[4];
#pragma unroll
    for (int j = 0; j < 4; ++j) { const int e0 = 32 * j + 8 * fq; grv[j] = *(const u32x4*)(GR + rowoff + e0); g0v[j] = *(const f32x4*)(rg + e0); g1v[j] = *(const f32x4*)(rg + e0 + 4); }
    __syncthreads();
    if (nxt) ro_load(F, un, *nxt);
#pragma unroll
    for (int ct = 0; ct < 8; ++ct) {
        f32x4 acc = {0.f, 0.f, 0.f, 0.f};
#pragma unroll
        for (int ks = 0; ks < 4; ++ks) { const bf16x8 b = *(const LAS bf16x8*)(Kl + (ct * 16 + fr) * MP + ks * 64 + fq * 16); acc = MFMA16(R.aq[ks], b, acc); }
#pragma unroll
        for (int r = 0; r < 4; ++r) {
            const int n = wave * 16 + fq * 4 + r, mm = ct * 16 + fr;
            const float v = (n >= mm) ? acc[r] * __builtin_amdgcn_exp2f((float)(n - mm) * lg2) : 0.f;
            *(LAS bf16_t*)(Sl + n * MP + mm * 2) = f2bf(v);
        }
    }
    __syncthreads();
    bf16x8 as[4];
#pragma unroll
    for (int ks = 0; ks < 4; ++ks) as[ks] = *(const LAS bf16x8*)(Sl + (wave * 16 + fr) * MP + ks * 64 + fq * 16);
    const float xi = __builtin_amdgcn_exp2f((float)(wave * 16 + fr + 1) * lg2);
    f32x4 y[8]; float ss = 0.f;
#pragma unroll
    for (int et = 0; et < 8; ++et) {
        f32x4 o = {0.f, 0.f, 0.f, 0.f}, cr = {0.f, 0.f, 0.f, 0.f};
#pragma unroll
        for (int ks = 0; ks < 4; ++ks) {
            const bf16x8 bv = *(const LAS bf16x8*)(Vt + (et * 16 + fr) * MP + ks * 64 + fq * 16); o = MFMA16(bv, as[ks], o);
            const bf16x8 br = *(const LAS bf16x8*)(Rl + (et * 16 + fr) * MP + ks * 64 + fq * 16); cr = MFMA16(br, R.aq[ks], cr);
        }
        y[et] = o + cr * xi;
        ss += (y[et][0] * y[et][0] + y[et][1] * y[et][1]) + (y[et][2] * y[et][2] + y[et][3] * y[et][3]);
    }
    ss = sum_fq(ss);
    const float rstd = __builtin_amdgcn_rsqf(ss * (1.0f / 128.0f) + EPS);
#pragma unroll
    for (int j = 0; j < 4; ++j) {
        const int e0 = 32 * j + 8 * fq;
        const u32x4 gr = grv[j]; const f32x4 g0 = g0v[j], g1 = g1v[j];
        f32x4 a = y[2 * j] * rstd * g0, b = y[2 * j + 1] * rstd * g1;
        a[0] *= bf_lo(gr[0]); a[1] *= bf_hi(gr[0]); a[2] *= bf_lo(gr[1]); a[3] *= bf_hi(gr[1]);
        b[0] *= bf_lo(gr[2]); b[1] *= bf_hi(gr[2]); b[2] *= bf_lo(gr[3]); b[3] *= bf_hi(gr[3]);
        u32x4 w; w.x = cvt_pk_bf16(a[0], a[1]); w.y = cvt_pk_bf16(a[2], a[3]); w.z = cvt_pk_bf16(b[0], b[1]); w.w = cvt_pk_bf16(b[2], b[3]);
        *(u32x4*)(YA + rowoff + e0) = w;
    }
    __syncthreads();
}
__device__ __forceinline__ void ret_out_units(Frame& F, int layer, int u0, int ustep) {
    for (int u = u0; u < 512; u += 2 * ustep) {
        RoRegs A, B; const int ub = u + ustep;
        ro_load(F, u, A);
        if (ub < 512) { ro_unit(F, layer, u, A, ub, &B); ro_unit(F, layer, ub, B, 0, nullptr); }
        else ro_unit(F, layer, u, A, 0, nullptr);
    }
}

__device__ __forceinline__ void sg_chunk(Frame& F, int layer, int c) {
    PHASE_IDS(); const int fr = lane & 15, fq = lane >> 4;
    LAS unsigned char* Vt = F.lds;
    const bf16_t* UB = (const bf16_t*)(F.ws + WS_SEG) + (size_t)4 * S * 512; const bf16_t* VB = (const bf16_t*)(F.ws + WS_SEG) + (size_t)5 * S * 512;
    bf16_t* YB = (bf16_t*)(F.ws + WS_YB);
    const int t0 = c * 128;
    const int row = wave * 16 + (lane >> 2), q4 = lane & 3;
    float mean, rstd;
    {
        const u32x4* vp = (const u32x4*)(VB + (size_t)(t0 + row) * 512 + q4 * 128);
        u32x4 raw[16]; float s = 0.f;
#pragma unroll
        for (int i = 0; i < 16; ++i) { raw[i] = vp[i];
#pragma unroll
            for (int j = 0; j < 4; ++j) s += bf_lo(raw[i][j]) + bf_hi(raw[i][j]); }
        s += __shfl_xor(s, 1); s += __shfl_xor(s, 2);
        mean = s * (1.0f / 512.0f); float q = 0.f;
#pragma unroll
        for (int i = 0; i < 16; ++i)
#pragma unroll
            for (int j = 0; j < 4; ++j) { const float a = bf_lo(raw[i][j]) - mean, b = bf_hi(raw[i][j]) - mean; q += a * a + b * b; }
        q += __shfl_xor(q, 1); q += __shfl_xor(q, 2);
        rstd = __builtin_amdgcn_rsqf(q * (1.0f / 512.0f) + EPS);
    }
    u32x4 rawA[4], rawB[4], ubA[4], ubB[4]; bf16x8 wA[4], wB[4];
#define SG_LOAD(g_, RAW, WF, UBV) do { \
        const u32x4* gp_ = (const u32x4*)(VB + (size_t)(t0 + row) * 512 + (g_) * 128 + q4 * 32); \
        const bf16_t* W_ = (const bf16_t*)(F.ws + WS_W + (size_t)layer * W_LAYER_B + WOFF_SG) + (size_t)(g_) * 16384; \
        _Pragma("unroll") for (int i = 0; i < 4; ++i) RAW[i] = gp_[i]; \
        _Pragma("unroll") for (int ks = 0; ks < 4; ++ks) WF[ks] = *(const bf16x8*)(W_ + (size_t)(wave * 16 + fr) * 128 + ks * 32 + fq * 8); \
        _Pragma("unroll") for (int j = 0; j < 4; ++j) UBV[j] = *(const u32x4*)(UB + (size_t)(t0 + wave * 16 + fr) * 512 + (g_) * 128 + 32 * j + 8 * fq); } while (0)
#define SG_GROUP(g_, RAW, WF, UBV, NEXT) do { \
        {     \
            const float* lg = inp(F, IN_SGLNG) + layer * 512 + (g_) * 128 + q4 * 32; const float* lb = inp(F, IN_SGLNB) + layer * 512 + (g_) * 128 + q4 * 32; \
            _Pragma("unroll") for (int i = 0; i < 4; ++i) { const u32x4 w = RAW[i]; \
                _Pragma("unroll") for (int j = 0; j < 4; ++j) { \
                    const int ch = i * 8 + 2 * j; \
                    const float a_ = (bf_lo(w[j]) - mean) * rstd * lg[ch] + lb[ch], b_ = (bf_hi(w[j]) - mean) * rstd * lg[ch + 1] + lb[ch + 1]; \
                    const unsigned pk = cvt_pk_bf16(a_, b_); \
                    *(LAS bf16_t*)(Vt + prow(q4 * 32 + ch) * MP + row * 2) = (bf16_t)(pk & 0xffffu); \
                    *(LAS bf16_t*)(Vt + prow(q4 * 32 + ch + 1) * MP + row * 2) = (bf16_t)(pk >> 16); \
                } } \
        } \
        const float bsn = inp(F, IN_SGB)[(layer * 4 + (g_)) * 128 + wave * 16 + fr]; \
        const size_t rowoff = (size_t)(t0 + wave * 16 + fr) * 512 + (g_) * 128; \
        __syncthreads(); \
        NEXT; \
        _Pragma("unroll") for (int j = 0; j < 4; ++j) {                        \
            f32x4 acc0 = {0.f, 0.f, 0.f, 0.f}, acc1 = {0.f, 0.f, 0.f, 0.f}; \
            _Pragma("unroll") for (int ks = 0; ks < 4; ++ks) { \
                const bf16x8 b0 = *(const LAS bf16x8*)(Vt + ((2 * j) * 16 + fr) * MP + ks * 64 + fq * 16); acc0 = MFMA16(b0, WF[ks], acc0); \
                const bf16x8 b1 = *(const LAS bf16x8*)(Vt + ((2 * j + 1) * 16 + fr) * MP + ks * 64 + fq * 16); acc1 = MFMA16(b1, WF[ks], acc1); \
            } \
            const int c0 = 32 * j + 8 * fq; \
            const u32x4 ub = UBV[j]; \
            u32x4 w; \
            w.x = cvt_pk_bf16(bf_lo(ub[0]) * (acc0[0] + bsn), bf_hi(ub[0]) * (acc0[1] + bsn)); w.y = cvt_pk_bf16(bf_lo(ub[1]) * (acc0[2] + bsn), bf_hi(ub[1]) * (acc0[3] + bsn)); \
            w.z = cvt_pk_bf16(bf_lo(ub[2]) * (acc1[0] + bsn), bf_hi(ub[2]) * (acc1[1] + bsn)); w.w = cvt_pk_bf16(bf_lo(ub[3]) * (acc1[2] + bsn), bf_hi(ub[3]) * (acc1[3] + bsn)); \
            *(u32x4*)(YB + rowoff + c0) = w; \
        } \
        __syncthreads(); } while (0)
    SG_LOAD(0, rawA, wA, ubA);
    SG_GROUP(0, rawA, wA, ubA, SG_LOAD(1, rawB, wB, ubB));
    SG_GROUP(1, rawB, wB, ubB, SG_LOAD(2, rawA, wA, ubA));
    SG_GROUP(2, rawA, wA, ubA, SG_LOAD(3, rawB, wB, ubB));
    SG_GROUP(3, rawB, wB, ubB, (void)0);
#undef SG_GROUP
#undef SG_LOAD
}

typedef int at_i32x4 __attribute__((ext_vector_type(4))); typedef int at_i32x8 __attribute__((ext_vector_type(8)));
#define MFMA32F8(a, b, c) __builtin_amdgcn_mfma_f32_32x32x16_fp8_fp8((a), (b), (c), 0, 0, 0)
#define KSWZ8(row, colB) ((row) * 128 + ((colB) ^ (((row) & 7) << 4)))
#define KSWZ(row, colB) ((row) * 256 + ((colB) ^ (((row) & 7) << 4)))
__device__ __forceinline__ int v_st(int k, int c) { const int kk = (k & ~0xC) | ((k & 4) << 1) | ((k & 8) >> 1); return ((kk >> 3) * 4 + (c >> 5)) * 512 + ((kk & 7) * 32 + (c & 31)) * 2; }
__device__ __forceinline__ int v_rd_base(int lane) { return ((lane & 3) << 3) | (((lane >> 2) & 3) << 6) | (((lane >> 4) & 1) << 5) | (((lane >> 5) & 1) << 8); }
constexpr int v_rd_off(int d0, int ks, int half) { return d0 * 512 + ks * 4096 + half * 2048; }
__device__ __forceinline__ int crow(int r, int hi) { return (r & 3) + 8 * (r >> 2) + 4 * hi; }
constexpr float AT_SCALE = 0.08838834764831845f, AT_THR = 8.f;
constexpr int AT_W = 129;
typedef __bf16 bf16x2v __attribute__((ext_vector_type(2)));
__device__ __forceinline__ float dot2sq(unsigned u, float c) { const bf16x2v v = __builtin_bit_cast(bf16x2v, u); return __builtin_amdgcn_fdot2_f32_bf16(v, v, c, false); }

__device__ __forceinline__ void at_pv32(f32x16* o, int vb0, bf16x8 pa0, bf16x8 pa1) {
#define TRRD(dst, off) asm volatile("ds_read_b64_tr_b16 %0, %1 offset:%2" : "=&v"(dst) : "v"(vb0), "i"(off) : "memory")
#define PV_D0(d0) do { s16x4 l0, l1, h0, h1; constexpr int b_ = v_rd_off(d0, 0, 0); \
        TRRD(l0, b_); TRRD(h0, b_ + 2048); TRRD(l1, b_ + 4096); TRRD(h1, b_ + 6144); \
        asm volatile("s_waitcnt lgkmcnt(0)" ::: "memory"); __builtin_amdgcn_sched_barrier(0); \
        o[d0] = MFMA32(pa0, ((bf16x8){l0[0], l0[1], l0[2], l0[3], h0[0], h0[1], h0[2], h0[3]}), o[d0]); \
        o[d0] = MFMA32(pa1, ((bf16x8){l1[0], l1[1], l1[2], l1[3], h1[0], h1[1], h1[2], h1[3]}), o[d0]); } while (0)
    PV_D0(0); PV_D0(1); PV_D0(2); PV_D0(3);
#undef PV_D0
#undef TRRD
}

__device__ __forceinline__ void rstd_fill(Frame& F, const float* ssq, const float* gq, const float* gk) {
    PHASE_IDS();
    if (gq && tid < 128) ((LAS float*)(F.lds + GW_OFF))[tid] = gq[tid] * gk[tid];
    if (gq && tid < 64) {
        float m = fmaxf(fabsf(gq[tid] * gk[tid]), fabsf(gq[tid + 64] * gk[tid + 64]));
#pragma unroll
        for (int o = 1; o < 64; o <<= 1) m = fmaxf(m, __shfl_xor(m, o));
        if (tid == 0) *(LAS float*)(F.lds + GWMAX_OFF) = m;
    }
    const int base = (bid & 7) * 2048;
    LAS float* rl = (LAS float*)(F.lds + RSTD_OFF);
    f32x4 a[4][4];
#pragma unroll
    for (int k = 0; k < 4; ++k)
#pragma unroll
        for (int j = 0; j < 4; ++j) a[k][j] = *(const f32x4*)(ssq + (size_t)(base + tid + 512 * k) * 16 + 4 * j);
#pragma unroll
    for (int k = 0; k < 4; ++k) { const f32x4 s4 = (a[k][0] + a[k][1]) + (a[k][2] + a[k][3]); const float s = (s4[0] + s4[1]) + (s4[2] + s4[3]);
        rl[tid + 512 * k] = __builtin_amdgcn_rsqf(s * (1.0f / D) + EPS); }
    __syncthreads();
}

struct RstdHook { Frame& F; const float* ssq; const float* gq; const float* gk; __device__ __forceinline__ void operator()() const { rstd_fill(F, ssq, gq, gk); } };

__device__ __forceinline__ void attn_unit(Frame& F, int layer, int g, int h, int b) {
    PHASE_IDS(); const int wid = wave, r32 = lane & 31, hi = lane >> 5;
    LAS unsigned char* V_lds = F.lds + wid * 16384; LAS unsigned char* K_lds = V_lds + 8192;
    LAS float* rk_l = (LAS float*)(F.lds + 131072 + wid * 512); LAS float* al_l = rk_l + 32; LAS float* li_l = rk_l + 64;
    const int sh = 2 * g, L = S >> sh, R0 = b * 256, P0 = R0 & (L - 1), seq0 = R0 - P0;
    const unsigned char* DILB = (const unsigned char*)(F.ws + WS_DIL); constexpr size_t TEN = (size_t)12 * S * 128 * 2;
    const size_t gh = (size_t)(g * 4 + h) * S;
    const unsigned char* Q8 = DILB + gh * 128; const float* NQ = (const float*)(DILB + DIL_NRM_OFF) + gh * 2;
    const unsigned char* K8 = DILB + TEN + (gh + seq0) * 128; const float* NK = (const float*)(DILB + TEN + DIL_NRM_OFF) + (gh + seq0) * 2;
    const bf16_t* Vg = (const bf16_t*)(DILB + 2 * TEN) + (gh + seq0) * 128;
    const int qlo = P0 + wid * 32, qm = qlo + r32 - 4 * hi;
    const int j0 = (qlo >= 128) ? 0 : ((128 - qlo) >> 5);
    const int skey = lane >> 4, sch = lane & 15, skey8 = lane >> 3, sch8 = lane & 7;
    u32x4 kreg[4], vreg[8]; f32x2 knrm;
    const unsigned kvo = (unsigned)(skey8 * 128 + sch8 * 16), vvo = (unsigned)(skey * 256 + sch * 16), nvo = (unsigned)(r32 * 8);
#define AT_LOADT(jj) do { const int kb_ = qlo - 128 + 32 * (jj); \
        const unsigned char* kt_ = K8 + (size_t)kb_ * 128; const unsigned char* vt_ = (const unsigned char*)Vg + (size_t)kb_ * 256; const unsigned char* nt_ = (const unsigned char*)NK + (size_t)kb_ * 8; \
        _Pragma("unroll") for (int i_ = 0; i_ < 4; ++i_) kreg[i_] = *(const u32x4*)(kt_ + kvo + i_ * 1024); \
        knrm = *(const f32x2*)(nt_ + nvo); \
        _Pragma("unroll") for (int i_ = 0; i_ < 8; ++i_) vreg[i_] = *(const u32x4*)(vt_ + vvo + i_ * 1024); } while (0)
    AT_LOADT(j0);
    at_i32x8 qr[2]; float rq;
    {
        const unsigned char* qrow = Q8 + (size_t)(R0 + wid * 32 + r32) * 128 + hi * 32;
#pragma unroll
        for (int m = 0; m < 2; ++m) { const at_i32x4 lo = *(const at_i32x4*)(qrow + m * 64), hi4 = *(const at_i32x4*)(qrow + m * 64 + 16); qr[m] = __builtin_shufflevector(lo, hi4, 0, 1, 2, 3, 4, 5, 6, 7); }
        const f32x2 nq = *(const f32x2*)(NQ + (size_t)(R0 + wid * 32 + r32) * 2);
        rq = __builtin_amdgcn_rsqf((nq.x + nq.y) * (1.0f / 128.0f) + EPS);
    }
    const int vb0 = (int)(unsigned)(size_t)V_lds + v_rd_base(lane);
    float m_reg = -1e30f, l_reg = 0.f; f32x16 o[4];
#pragma unroll
    for (int d = 0; d < 4; ++d)
#pragma unroll
        for (int r = 0; r < 16; ++r) o[d][r] = 0.f;
    const float SCq = AT_SCALE * rq, C2q = 1.4426950408889634f * SCq;
    const float Ms = __builtin_bit_cast(float, __builtin_amdgcn_readfirstlane(__builtin_bit_cast(int, 13.0f * *(const LAS float*)(F.lds + GWMAX_OFF)))); const bool fixed = Ms <= 80.0f;
    const float mnLfix = -Ms * 1.4426950408889634f;
#ifndef REPTILE
#define REPTILE 1
#endif
    for (int rt_ = 0; rt_ < REPTILE; ++rt_) {
    if (rt_ > 0) { m_reg = -1e30f; l_reg = 0.f;
#pragma unroll
        for (int d = 0; d < 4; ++d)
#pragma unroll
            for (int r = 0; r < 16; ++r) o[d][r] = 0.f;
        AT_LOADT(j0); }
    for (int j = j0; j < 5; ++j) {
        const int kb = qlo - 128 + 32 * j;
        asm volatile("s_waitcnt lgkmcnt(0)" ::: "memory");
#pragma unroll
        for (int i = 0; i < 4; ++i) *(LAS u32x4*)(K_lds + KSWZ8(8 * i + skey8, sch8 * 16)) = kreg[i];
#pragma unroll
        for (int i = 0; i < 8; ++i) *(LAS u32x4*)(V_lds + v_st(4 * i + skey, sch * 8)) = vreg[i];
        if (hi == 0) rk_l[r32] = __builtin_amdgcn_rsqf((knrm.x + knrm.y) * (1.0f / 128.0f) + EPS);
        if (j < 4) AT_LOADT(j + 1);
        asm volatile("s_waitcnt lgkmcnt(0)" ::: "memory");
        f32x16 p0;
#pragma unroll
        for (int r = 0; r < 16; ++r) p0[r] = 0.f;
#pragma unroll
        for (int m = 0; m < 2; ++m) { const int c0 = 4 * m + 2 * hi;
            const at_i32x4 lo = *(const LAS at_i32x4*)(K_lds + r32 * 128 + ((c0 ^ (r32 & 7)) << 4)), hi4 = *(const LAS at_i32x4*)(K_lds + r32 * 128 + (((c0 + 1) ^ (r32 & 7)) << 4));
            p0 = __builtin_amdgcn_mfma_scale_f32_32x32x64_f8f6f4(__builtin_shufflevector(lo, hi4, 0, 1, 2, 3, 4, 5, 6, 7), qr[m], p0, 0, 0, 0, 0, 0, 0); }
        if (j == 0 || j == 4) {
            const int dq = qm - kb; const float NEG = -__builtin_inff();
#pragma unroll
            for (int rg = 0; rg < 4; ++rg) { const f32x4 rk4 = *(const LAS f32x4*)(rk_l + 8 * rg + 4 * hi);
#pragma unroll
                for (int q = 0; q < 4; ++q) { const int r = 4 * rg + q, cc = q + 8 * rg; p0[r] = ((unsigned)(dq - cc) < (unsigned)AT_W) ? p0[r] * rk4[q] : NEG; } }
        } else {
#pragma unroll
            for (int rg = 0; rg < 4; ++rg) { const f32x4 rk4 = *(const LAS f32x4*)(rk_l + 8 * rg + 4 * hi);
#pragma unroll
                for (int q = 0; q < 4; ++q) p0[4 * rg + q] *= rk4[q]; }
        }
        float alpha = 1.f, mnL = mnLfix;
        if (!fixed) {
            float pmax = p0[0];
#pragma unroll
            for (int r = 1; r < 16; ++r) pmax = fmaxf(pmax, p0[r]);
            pmax = fmaxf(pmax, __shfl_xor(pmax, 32));
            float mn;
            if (__all((pmax - m_reg) * SCq <= AT_THR)) { mn = m_reg; }
            else { mn = fmaxf(m_reg, pmax); alpha = __builtin_amdgcn_exp2f((m_reg - mn) * C2q); m_reg = mn; }
            mnL = -mn * C2q;
        }
        float ps = 0.f;
#pragma unroll
        for (int r = 0; r < 16; ++r) { p0[r] = __builtin_amdgcn_exp2f(fmaf(p0[r], C2q, mnL)); ps += p0[r]; }
        ps += __shfl_xor(ps, 32);
        l_reg = l_reg * alpha + ps;
        bf16x8 pa0, pa1;
#define PK4(P, B_, OUT) do { unsigned a0 = cvt_pk_bf16(P[B_+0], P[B_+1]), a1 = cvt_pk_bf16(P[B_+2], P[B_+3]); \
        unsigned b0_ = cvt_pk_bf16(P[B_+4], P[B_+5]), b1_ = cvt_pk_bf16(P[B_+6], P[B_+7]); \
        auto r0_ = __builtin_amdgcn_permlane32_swap(a0, b0_, false, false); auto r1_ = __builtin_amdgcn_permlane32_swap(a1, b1_, false, false); \
        u32x4 w_ = {r0_[0], r1_[0], r0_[1], r1_[1]}; OUT = __builtin_bit_cast(bf16x8, w_); } while (0)
        PK4(p0, 0, pa0); PK4(p0, 8, pa1);
#undef PK4
        if (!fixed && __any(alpha < 1.f)) {
            if (hi == 0) al_l[r32] = alpha;
            LDS_WAIT();
#pragma unroll
            for (int rg = 0; rg < 4; ++rg) { const f32x4 a4 = *(const LAS f32x4*)(al_l + 8 * rg + 4 * hi);
#pragma unroll
                for (int q = 0; q < 4; ++q)
#pragma unroll
                    for (int d = 0; d < 4; ++d) o[d][4 * rg + q] *= a4[q]; }
        }
        at_pv32(o, vb0, pa0, pa1);
    }
    }
#undef AT_LOADT
    if (hi == 0) li_l[r32] = l_reg;
    LDS_WAIT();
    LAS unsigned char* O_lds = V_lds;
#pragma unroll
    for (int rg = 0; rg < 4; ++rg) { const f32x4 l4 = *(const LAS f32x4*)(li_l + 8 * rg + 4 * hi);
#pragma unroll
        for (int q = 0; q < 4; ++q) { const float rl = __builtin_amdgcn_rcpf(l4[q]); const int row = q + 8 * rg + 4 * hi, r = 4 * rg + q;
            *(LAS unsigned*)(O_lds + row * 128 + r32 * 4) = fp8x4((f32x4){o[0][r] * rl, o[1][r] * rl, o[2][r] * rl, o[3][r] * rl}); } }
    LDS_WAIT();
    unsigned char* OG8 = F.ws + WS_OG + (size_t)g * S * 512;
#pragma unroll
    for (int i = 0; i < 4; ++i) {
        const int id = lane + 64 * i, row = id >> 3, cc = id & 7;
        const int Rr = R0 + wid * 32 + row, tok = ((Rr & (L - 1)) << sh) + (Rr >> (14 - sh));
        *(u32x4*)(OG8 + (size_t)tok * 512 + h * 128 + cc * 16) = *(const LAS u32x4*)(O_lds + row * 128 + cc * 16);
    }
    if (hi == 0) {
        float* LSE = (float*)(F.ws + WS_LSE) + (size_t)g * S * 4;
        const int Rr = R0 + wid * 32 + r32; const int tok = ((Rr & (L - 1)) << sh) + (Rr >> (14 - sh));
        LSE[(size_t)tok * 4 + h] = (fixed ? Ms : m_reg * SCq) + logf(l_reg);
    }
    LDS_WAIT();
}

__device__ __forceinline__ void attn_combine(Frame& F) {
    const unsigned char* OG8 = F.ws + WS_OG; const float* LSE = (const float*)(F.ws + WS_LSE); bf16_t* YC = (bf16_t*)(F.ws + WS_YC);
    PHASE_IDS();
    const int gt = bid * 384 + (tid - 128), NGT = F.G * 384; constexpr int NIT = S * 16;
    for (int i0 = gt; i0 < NIT; i0 += 3 * NGT) {
        u32x4 a[3][2], bq[3][2], cq[3][2]; float l0[3], l1[3], l2[3];
#pragma unroll
        for (int k = 0; k < 3; ++k) {
            const int iu = i0 + k * NGT, i = iu < NIT ? iu : NIT - 1, tok = i >> 4, h = (i >> 2) & 3, c2 = i & 3; const size_t off = (size_t)tok * 512 + h * 128 + c2 * 32;
            l0[k] = LSE[(size_t)tok * 4 + h]; l1[k] = LSE[(size_t)S * 4 + (size_t)tok * 4 + h]; l2[k] = LSE[(size_t)2 * S * 4 + (size_t)tok * 4 + h];
#pragma unroll
            for (int hf = 0; hf < 2; ++hf) { a[k][hf] = *(const u32x4*)(OG8 + off + hf * 16); bq[k][hf] = *(const u32x4*)(OG8 + (size_t)S * 512 + off + hf * 16); cq[k][hf] = *(const u32x4*)(OG8 + (size_t)2 * S * 512 + off + hf * 16); }
        }
#pragma unroll
        for (int k = 0; k < 3; ++k) {
            const int i = i0 + k * NGT, tok = i >> 4, h = (i >> 2) & 3, c2 = i & 3;
            if (i >= NIT) continue;
            const float mx = fmaxf(l0[k], fmaxf(l1[k], l2[k]));
            float w0 = __expf(l0[k] - mx), w1 = __expf(l1[k] - mx), w2 = __expf(l2[k] - mx); const float inv = 1.0f / (w0 + w1 + w2); w0 *= inv; w1 *= inv; w2 *= inv;
            float y[4][8];
#pragma unroll
            for (int j = 0; j < 8; ++j) {
                const unsigned wa = a[k][j >> 2][j & 3], wb = bq[k][j >> 2][j & 3], wc_ = cq[k][j >> 2][j & 3];
                const f32x2 a01 = __builtin_amdgcn_cvt_pk_f32_fp8((int)wa, false), a23 = __builtin_amdgcn_cvt_pk_f32_fp8((int)wa, true);
                const f32x2 b01 = __builtin_amdgcn_cvt_pk_f32_fp8((int)wb, false), b23 = __builtin_amdgcn_cvt_pk_f32_fp8((int)wb, true);
                const f32x2 c01 = __builtin_amdgcn_cvt_pk_f32_fp8((int)wc_, false), c23 = __builtin_amdgcn_cvt_pk_f32_fp8((int)wc_, true);
                y[0][j] = w0 * a01.x + w1 * b01.x + w2 * c01.x; y[1][j] = w0 * a01.y + w1 * b01.y + w2 * c01.y;
                y[2][j] = w0 * a23.x + w1 * b23.x + w2 * c23.x; y[3][j] = w0 * a23.y + w1 * b23.y + w2 * c23.y;
            }
            bf16_t* yp = YC + (size_t)tok * 512 + h * 128 + c2 * 8;
#pragma unroll
            for (int kk = 0; kk < 4; ++kk) { u32x4 w; w.x = cvt_pk_bf16(y[kk][0], y[kk][1]); w.y = cvt_pk_bf16(y[kk][2], y[kk][3]); w.z = cvt_pk_bf16(y[kk][4], y[kk][5]); w.w = cvt_pk_bf16(y[kk][6], y[kk][7]);
                *(u32x4*)(yp + kk * 32) = w; }
        }
    }
}
#define XB_TMO      128
#define XB_XCNT(j)  (256  + 64 * (j))
#define XB_XSUB(j)  (1280 + 64 * (j))
#define XB_XGEN(j)  (2304 + 64 * (j))
#define XB_TOP      3328
#define XB_TOPGEN   3392
#define XCD_BAR_WORDS 3456
#define XB_SPIN_CAP (1u << 18)

__device__ __forceinline__ unsigned xb_ld(unsigned* p)              { return __hip_atomic_load(p, __ATOMIC_RELAXED, __HIP_MEMORY_SCOPE_AGENT); }
__device__ __forceinline__ unsigned xb_add(unsigned* p, unsigned v) { return __hip_atomic_fetch_add(p, v, __ATOMIC_RELAXED, __HIP_MEMORY_SCOPE_AGENT); }
__device__ __forceinline__ unsigned xb_xcc_id() { return (unsigned)__builtin_amdgcn_s_getreg((3 << 11) | 20) & 0xFu; }
#define XB_SPIN(cond, bar) do { unsigned _sp = 0; while (cond) { __builtin_amdgcn_s_sleep(1); \
    if ((++_sp & 255u) == 0u) { if (xb_ld(&(bar)[XB_TMO])) break; if (_sp > XB_SPIN_CAP) { atomicAdd(&(bar)[XB_TMO], 1u); break; } } } } while (0)

struct XcdBarrier {
    unsigned* bar; unsigned x;
    volatile LAS unsigned* st;
};

__device__ __forceinline__ XcdBarrier xcd_barrier_post(unsigned* bar, volatile LAS unsigned* st) {
    XcdBarrier b; b.bar = bar; b.x = xb_xcc_id(); b.st = st;
    if (threadIdx.x == 0) (void)xb_add(&bar[XB_XCNT(b.x)], 1u);
    return b;
}
__device__ __forceinline__ void xcd_barrier_complete(unsigned* bar, unsigned x, unsigned& nloc, unsigned& nx) {
    const unsigned G = gridDim.x * gridDim.y * gridDim.z;
    unsigned sum, cnt, mine, sp = 0u;
    for (;;) {
        sum = 0u; cnt = 0u; mine = 0u;
#pragma unroll
        for (unsigned j = 0; j < 16; ++j) { const unsigned c = xb_ld(&bar[XB_XCNT(j)]); sum += c; cnt += (c > 0u) ? 1u : 0u; mine = (j == x) ? c : mine; }
        if (sum == G) break;
        __builtin_amdgcn_s_sleep(1);
        if ((++sp & 255u) == 0u) { if (xb_ld(&bar[XB_TMO])) break; if (sp > XB_SPIN_CAP) { atomicAdd(&bar[XB_TMO], 1u); break; } }
    }
    nloc = mine > 0u ? mine : 1u; nx = cnt > 0u ? cnt : 1u;
}

__device__ __forceinline__ void xcd_barrier(const XcdBarrier& b) {
    asm volatile("s_waitcnt vmcnt(0)" ::: "memory");
    __syncthreads();
    if (threadIdx.x == 0) {
        unsigned* bar = b.bar;
        __builtin_amdgcn_s_waitcnt(0);
        unsigned nloc = b.st[0], nx = b.st[1];
        if (nloc == 0u) { xcd_barrier_complete(bar, b.x, nloc, nx); b.st[0] = nloc; b.st[1] = nx; }
        const unsigned old = xb_add(&bar[XB_XSUB(b.x)], 1u);
        const unsigned gen = old / nloc;
        if (old + 1u == (gen + 1u) * nloc) {
            __builtin_amdgcn_fence(__ATOMIC_RELEASE, "agent");
            asm volatile("s_waitcnt vmcnt(0)" ::: "memory");
            const unsigned og = xb_add(&bar[XB_TOP], 1u);
            const unsigned tg = og / nx;
#ifdef BAR_EARLY_INV
            if (og + 1u == (tg + 1u) * nx) { xb_add(&bar[XB_TOPGEN], 1u); asm volatile("buffer_inv sc1" ::: "memory"); }
            else { asm volatile("buffer_inv sc1" ::: "memory"); XB_SPIN(xb_ld(&bar[XB_TOPGEN]) == tg, bar); }
#else
            if (og + 1u == (tg + 1u) * nx) xb_add(&bar[XB_TOPGEN], 1u);
            else XB_SPIN(xb_ld(&bar[XB_TOPGEN]) == tg, bar);
#endif
#ifndef BAR_EARLY_INV
            __builtin_amdgcn_fence(__ATOMIC_ACQUIRE, "agent");
#endif
            asm volatile("s_waitcnt vmcnt(0)" ::: "memory");
        } else {
#ifdef BAR_EARLY_INV
            asm volatile("buffer_inv sc1" ::: "memory");
#endif
            XB_SPIN(xb_ld(&bar[XB_TOPGEN]) == gen, bar);
#ifndef BAR_EARLY_INV
            __builtin_amdgcn_fence(__ATOMIC_ACQUIRE, "agent");
#endif
            asm volatile("s_waitcnt vmcnt(0)" ::: "memory");
        }
    }
    __syncthreads();
}

#define XL_TAB(g)  (4096 + 64 * (g))
#define XL_MIS     (4096 + 512)
#define XL_SUB(g)  (4096 + 1024 + 64 * (g))
#define XL_GEN(g)  (4096 + 2048 + 64 * (g))
__device__ __forceinline__ void xl_post(unsigned* bar, unsigned x) {
    const unsigned g = blockIdx.x & 7u, want = x + 1u;
    const unsigned prev = atomicCAS(&bar[XL_TAB(g)], 0u, want);
    if ((prev != 0u && prev != want) || (gridDim.x & 7u) != 0u) atomicOr(&bar[XL_MIS], 1u);
}
__device__ __forceinline__ void xcd_local_barrier(const XcdBarrier& b) {
    asm volatile("s_waitcnt vmcnt(0)" ::: "memory");
    __syncthreads();
    if (threadIdx.x == 0) {
        unsigned* bar = b.bar; const unsigned g = blockIdx.x & 7u, gsize = gridDim.x >> 3;
        __builtin_amdgcn_s_waitcnt(0);
        const unsigned gen = b.st[3]; b.st[3] = gen + 1u;
        const unsigned old = xb_add(&bar[XL_SUB(g)], 1u);
        if (old + 1u == (gen + 1u) * gsize) { xb_add(&bar[XL_GEN(g)], 1u); asm volatile("buffer_inv sc1" ::: "memory"); }
        else { asm volatile("buffer_inv sc1" ::: "memory"); XB_SPIN(xb_ld(&bar[XL_GEN(g)]) == gen, bar); }
        asm volatile("s_waitcnt vmcnt(0)" ::: "memory");
    }
    __syncthreads();
}

struct Args { const float* in[15]; float* out; unsigned char* ws; int ph_lo, ph_hi, li, pad; };
__global__ void __launch_bounds__(NTHREADS, 2) trunk_fwd(Args args) {
    extern __shared__ __attribute__((aligned(16))) unsigned char lds_raw[];
    Frame F;
    F.lds = (LAS unsigned char*)lds_raw;
    F.tid = threadIdx.x;
    F.G = gridDim.x; F.bid = blockIdx.x;
    F.ws = args.ws;
    volatile LAS unsigned* MISC = (volatile LAS unsigned*)(F.lds + MISC_OFF);
    if (F.tid < 16) MISC[F.tid] = 0u;
    if (F.tid == 64) { const float* LAS* tb = (const float* LAS*)(F.lds + MISC_OFF + 64);
        tb[0] = args.in[0]; tb[1] = args.in[1]; tb[2] = args.in[2]; tb[3] = args.in[3]; tb[4] = args.in[4]; tb[5] = args.in[5]; tb[6] = args.in[6]; tb[7] = args.in[7];
        tb[8] = args.in[8]; tb[9] = args.in[9]; tb[10] = args.in[10]; tb[11] = args.in[11]; tb[12] = args.in[12]; tb[13] = args.in[13]; tb[14] = args.in[14]; tb[15] = args.out; }
    __syncthreads();
    unsigned* ctl = (unsigned*)(F.ws + WS_CTL);
    XcdBarrier bar; bar.bar = ctl + CW_BAR; bar.x = 0; bar.st = nullptr;
    if (MK_N_LAUNCHES == 1) { bar = xcd_barrier_post(ctl + CW_BAR, MISC); if (F.tid == 0) xl_post(ctl + CW_BAR, bar.x); }
#ifdef PROBE_BAR2
#define GRID_BAR() do { if (MK_N_LAUNCHES == 1) { xcd_barrier(bar); xcd_barrier(bar); } } while (0)
#else
#define GRID_BAR() do { if (MK_N_LAUNCHES == 1) xcd_barrier(bar); } while (0)
#endif
#ifndef LOCAL_SEAMS
#define LOCAL_SEAMS 1
#endif
#define GROUP_BAR() do { if (MK_N_LAUNCHES == 1) { if (LOCAL_SEAMS && MISC[2] == 1u) xcd_local_barrier(bar); else xcd_barrier(bar); } } while (0)
#define OPAQUE_BID() Frame& P = F; const int pbid = F.bid
#ifndef ATT_XCD_DEAL
#define ATT_XCD_DEAL 0
#endif
#ifndef GSP2
#define GSP2 true
#endif
#ifndef F8SEL
#define F8SEL true
#endif
#ifndef GSP2_F8
#define GSP2_F8 GSP2
#endif
#ifndef ALIGN_F8
#define ALIGN_F8 true
#endif
#ifndef ALIGN_IN
#define ALIGN_IN true
#endif
#ifndef STAGGER_TICKS
#define STAGGER_TICKS 0
#endif
#define STAGGER(ntn) do { if (STAGGER_TICKS > 0 && (pbid & 32)) { for (int i_ = 0; i_ < STAGGER_TICKS; ++i_) __builtin_amdgcn_s_sleep(12); } } while (0)
#if MK_N_LAUNCHES == 1
    constexpr int lo = 0, hi = N_PHASES;
#else
    const int lo = args.ph_lo, hi = args.ph_hi;
#endif
#ifndef PHMASK
#define PHMASK 0x1ff
#endif
#define PHON(j) (((PHMASK) >> (j)) & 1)
#ifndef REPMASK
#define REPMASK 0
#endif
#define NREP(j) (1 + (((REPMASK) >> (j)) & 1))
#ifndef REPSUB
#define REPSUB 0
#endif
#define NSUB(j) (1 + (((REPSUB) >> (j)) & 1))
#define IN(k) (lo <= (k) && (k) < hi)
#define BOTH(k) (IN(k) && IN((k) + 1))

    for (int rep_ = 0; rep_ < NREP(0); ++rep_) if (PHON(0) && IN(0)) { p0_prologue(F); if (BOTH(0)) GRID_BAR(); }
    if (MK_N_LAUNCHES == 1) { if (F.tid == 0) MISC[2] = (xb_ld(ctl + CW_BAR + XL_MIS) == 0u) ? 1u : 2u; __syncthreads(); }

#define ssq_mix ((float*)(P.ws + WS_SSQ))
#define ssq_ffn ((float*)(P.ws + WS_SSQ + 1 * MiB))
#define XB ((bf16_t*)(P.ws + WS_XB))
#define wl (P.ws + WS_W + (size_t)l * W_LAYER_B)
    for (int l = 0; l < DEPTH; ++l) {
        const int pb0 = 1 + l * PH_PER_LAYER;
        for (int rep_ = 0; rep_ < NREP(1); ++rep_) if (PHON(1) && IN(pb0 + 0)) { OPAQUE_BID(); STAGGER(0);
#if F8_TILES == 6
            pg8::Gemm g8{(const bf16_t*)(P.ws + WS_XB8), (const bf16_t*)(P.ws + WS_XB8), (const bf16_t*)(P.ws + WS_XB8), (const bf16_t*)(wl + WOFF_IN8), 0, D / 2};
            pg8::StaticOrder So8; So8.init(S, 30 * 256, P.G, pbid, 1, 12); So8.gap(1 << 20, 0, 1);
            pg8::Gemm g{XB, XB, XB, (const bf16_t*)(wl + WOFF_IN), 0, D}; pg8::StaticOrder So; So.init(S, 12 * 256, P.G, pbid);
            constexpr int NBF = 30;
#elif F8_TILES == 5
            pg8::Gemm g8{(const bf16_t*)(P.ws + WS_XB8), (const bf16_t*)(P.ws + WS_XB8), (const bf16_t*)(P.ws + WS_XB8), (const bf16_t*)(wl + WOFF_IN8), 0, D / 2};
            pg8::StaticOrder So8; So8.init(S, 22 * 256, P.G, pbid, 1, 12); So8.gap(18, 8, 1);
            pg8::Gemm g{XB, XB, XB, (const bf16_t*)(wl + WOFF_IN), 0, D}; pg8::StaticOrder So; So.init(S, 20 * 256, P.G, pbid); So.gap(12, 18, 0);
            constexpr int NBF = 22;
#define F8_LAST 1
#elif F8_TILES == 4
            pg8::Gemm g8{(const bf16_t*)(P.ws + WS_XB8), (const bf16_t*)(P.ws + WS_XB8), (const bf16_t*)(P.ws + WS_XB8), (const bf16_t*)(wl + WOFF_IN8), 0, D / 2};
            pg8::StaticOrder So8; So8.init(S, 24 * 256, P.G, pbid); So8.gap(6, 6, 1);
            pg8::Gemm g{XB, XB, XB, (const bf16_t*)(wl + WOFF_IN), 0, D}; pg8::StaticOrder So; So.init(S, 18 * 256, P.G, pbid, 1, 6); So.gap(6, 18, 0);
            constexpr int NBF = 18;
#elif F8_TILES == 3
            pg8::Gemm g8{(const bf16_t*)(P.ws + WS_XB8), (const bf16_t*)(P.ws + WS_XB8), (const bf16_t*)(P.ws + WS_XB8), (const bf16_t*)(wl + WOFF_IN8), 0, D / 2};
            pg8::StaticOrder So8; So8.init(S, 24 * 256, P.G, pbid, 1, 12); So8.gap(12, 6, 1);
            pg8::Gemm g{XB, XB, XB, (const bf16_t*)(wl + WOFF_IN), 0, D}; pg8::StaticOrder So; So.init(S, 18 * 256, P.G, pbid); So.gap(12, 12, 0);
            constexpr int NBF = 18;
#elif F8_TILES == 2
            pg8::Gemm g8{(const bf16_t*)(P.ws + WS_XB8), (const bf16_t*)(P.ws + WS_XB8), (const bf16_t*)(P.ws + WS_XB8), (const bf16_t*)(wl + WOFF_IN8 + (size_t)12 * 256 * D), 0, D / 2};
            pg8::StaticOrder So8; So8.init(S, 12 * 256, P.G, pbid, 1, 30); So8.gap(1 << 20, 0, 1);
            pg8::Gemm g{XB, XB, XB, (const bf16_t*)(wl + WOFF_IN), 0, D}; pg8::StaticOrder So; So.init(S, 30 * 256, P.G, pbid);
            constexpr int NBF = 30;
#else
            pg8::Gemm g8{(const bf16_t*)(P.ws + WS_XB8), (const bf16_t*)(P.ws + WS_XB8), (const bf16_t*)(P.ws + WS_XB8), (const bf16_t*)(wl + WOFF_IN8), 0, D / 2};
            pg8::StaticOrder So8; So8.init(S, 12 * 256, P.G, pbid, 1, 12); So8.gap(1 << 20, 0, 1);
            pg8::Gemm g{XB, XB, XB, (const bf16_t*)(wl + WOFF_IN), 0, D}; pg8::StaticOrder So; So.init(S, 30 * 256, P.G, pbid); So.gap(12, 12, 0);
            constexpr int NBF = 30;
#endif
            const RstdHook rh{P, ssq_mix, inp(P, IN_DILQG) + l * 128, inp(P, IN_DILKG) + l * 128};
            EpiIn E{(const LAS float*)(P.lds + RSTD_OFF), (const float*)(P.ws + WS_CS), (bf16_t*)(P.ws + WS_SEG), (bf16_t*)(P.ws + WS_DIL), (unsigned char*)(P.ws + WS_GT), (const LAS float*)(P.lds + GW_OFF)};
#ifdef PROBE_KLOOP
            if (PROBE_KLOOP & 1) { EpiNull En; pg8::gemm_phase<EpiNull, pg8::StaticOrder, true, GSP2>(P.lds, g, So, En); __syncthreads(); }
#endif
#ifdef F8_LAST
            pg8::gemm_phase<EpiIn, pg8::StaticOrder, ALIGN_IN, GSP2, false, false, RstdHook>(P.lds, g, So, E, rh);
            pg8::gemm_phase<EpiIn, pg8::StaticOrder, ALIGN_F8, GSP2_F8, false, F8SEL>(P.lds, g8, So8, E);
#else
            pg8::gemm_phase<EpiIn, pg8::StaticOrder, ALIGN_F8, GSP2_F8, false, F8SEL, RstdHook>(P.lds, g8, So8, E, rh);
            pg8::gemm_phase<EpiIn, pg8::StaticOrder, ALIGN_IN, GSP2>(P.lds, g, So, E);
#endif
            p0_side(P, l, 0, (S / 256) * NBF);
            if (BOTH(pb0 + 0)) GRID_BAR();
        }
        for (int rep_ = 0; rep_ < NREP(2); ++rep_) if (PHON(2) && IN(pb0 + 1)) { OPAQUE_BID();
            for (int rs_ = 0; rs_ < NSUB(0); ++rs_) for (int u = pbid; u < 768; u += P.G) { const int g = u >> 8, r = u & 255; attn_unit(P, l, g, r >> 6, r & 63); }
            __syncthreads();
            { const int hg = P.G >> 1;
              if (pbid < hg) { for (int rs_ = 0; rs_ < NSUB(1); ++rs_) for (int c = pbid; c < 128; c += hg) sg_chunk(P, l, c); }
              else { for (int rs_ = 0; rs_ < NSUB(2); ++rs_) ret_kv_units(P, pbid - hg, P.G - hg); } }
            if (BOTH(pb0 + 1)) GRID_BAR();
        }
        for (int rep_ = 0; rep_ < NREP(3); ++rep_) if (PHON(3) && IN(pb0 + 2)) { OPAQUE_BID();
            if (__builtin_amdgcn_readfirstlane(P.tid >> 6) < 2) { for (int rs_ = 0; rs_ < NSUB(3); ++rs_) ret_scan(F); }
            else { for (int rs_ = 0; rs_ < NSUB(4); ++rs_) attn_combine(F); }
            if (BOTH(pb0 + 2)) GRID_BAR();
        }
        for (int rep_ = 0; rep_ < NREP(4); ++rep_) if (PHON(4) && IN(pb0 + 3)) { OPAQUE_BID();
            for (int rs_ = 0; rs_ < NSUB(5); ++rs_) ret_out_units(P, l, pbid, P.G);
            if (BOTH(pb0 + 3)) GRID_BAR();
        }
        for (int rep_ = 0; rep_ < NREP(5); ++rep_) if (PHON(5) && IN(pb0 + 4)) { OPAQUE_BID();
            pg8::Gemm g{(const bf16_t*)(P.ws + WS_YA), (const bf16_t*)(P.ws + WS_YB), (const bf16_t*)(P.ws + WS_YC), (const bf16_t*)(wl + WOFF_B), (size_t)D * 512, 512};
            pg8::StaticOrder So; So.init(S, D, P.G, pbid, 3);
            EpiMerge E{(const unsigned char*)(P.ws + WS_GT), (bf16_t*)(P.ws + WS_MERGED)};
            pg8::gemm_phase<EpiMerge, pg8::StaticOrder, true, GSP2>(P.lds, g, So, E);
            if (BOTH(pb0 + 4)) GROUP_BAR();
        }
        for (int rep_ = 0; rep_ < NREP(6); ++rep_) if (PHON(6) && IN(pb0 + 5)) { OPAQUE_BID();
            const bf16_t* A = (const bf16_t*)(P.ws + WS_MERGED);
            pg8::Gemm g{A, A, A, (const bf16_t*)(wl + WOFF_O), 0, D}; pg8::StaticOrder So; So.init(S, D, P.G, pbid);
            EpiRes E{(l == 0) ? inp(P, IN_X) : (const float*)nullptr, (float*)nullptr, XB, ssq_ffn, (unsigned char*)nullptr};
#ifdef PROBE_KLOOP
            if (PROBE_KLOOP & 8) { EpiNull En; pg8::gemm_phase<EpiNull, pg8::StaticOrder, false, GSP2>(P.lds, g, So, En); __syncthreads(); }
#endif
            pg8::gemm_phase<EpiRes, pg8::StaticOrder, false, GSP2>(P.lds, g, So, E);
            if (BOTH(pb0 + 5)) GROUP_BAR();
        }
        for (int rep_ = 0; rep_ < NREP(7); ++rep_) if (PHON(7) && IN(pb0 + 6)) { OPAQUE_BID(); STAGGER(0);
            pg8::Gemm g{XB, XB, XB, (const bf16_t*)(wl + WOFF_GU), 0, D}; pg8::StaticOrder So; So.init(S, NGU, P.G, pbid);
            const RstdHook rh{P, ssq_ffn, nullptr, nullptr};
            EpiGU E{(const LAS float*)(P.lds + RSTD_OFF), (bf16_t*)(P.ws + WS_ACT)};
#ifdef PROBE_KLOOP
            if (PROBE_KLOOP & 2) { EpiNull En; pg8::gemm_phase<EpiNull, pg8::StaticOrder, true, GSP2>(P.lds, g, So, En); __syncthreads(); }
#endif
            pg8::gemm_phase<EpiGU, pg8::StaticOrder, ALIGN_IN, GSP2, false, false, RstdHook>(P.lds, g, So, E, rh);
            p0_side(P, l, 1, (S / 256) * (NGU / 256));
            if (BOTH(pb0 + 6)) GRID_BAR();
        }
        for (int rep_ = 0; rep_ < NREP(8); ++rep_) if (PHON(8) && IN(pb0 + 7)) { OPAQUE_BID();
            const bf16_t* A = (const bf16_t*)(P.ws + WS_ACT);
            pg8::Gemm g{A, A, A, (const bf16_t*)(wl + WOFF_D), 0, DFF}; pg8::StaticOrder So; So.init(S, D, P.G, pbid);
            EpiRes E{(const float*)nullptr, (l == DEPTH - 1) ? (float*)inp(P, IN_OUT) : (float*)nullptr, XB, ssq_mix, (l == DEPTH - 1) ? (unsigned char*)nullptr : P.ws + WS_XB8};
#ifdef PROBE_KLOOP
            if (PROBE_KLOOP & 4) { EpiNull En; pg8::gemm_phase<EpiNull, pg8::StaticOrder, false, GSP2>(P.lds, g, So, En); __syncthreads(); }
#endif
            pg8::gemm_phase<EpiRes, pg8::StaticOrder, false, GSP2>(P.lds, g, So, E);
            if (BOTH(pb0 + 7)) GRID_BAR();
        }
    }
#undef IN
#undef BOTH
#undef ssq_mix
#undef ssq_ffn
#undef XB
#undef wl
}

extern "C" void kernel_launch(void* const* d_in, const int* in_sizes, int n_in, void* d_out, int out_size, void* d_ws, size_t ws_size, hipStream_t stream) {
    static int grid = 0;
    if (grid == 0) {
        if (n_in != 15 || in_sizes[0] != S * D || out_size != S * D || ws_size < WS_END) { fprintf(stderr, "kernel_launch: unexpected shapes (n_in %d, in0 %d, out %d, ws %zu); nothing launched\n", n_in, n_in > 0 ? in_sizes[0] : -1, out_size, ws_size); grid = -1; return; }
        int dev = 0, cus = 0, per_cu = 0;
        if (hipGetDevice(&dev) != hipSuccess || hipDeviceGetAttribute(&cus, hipDeviceAttributeMultiprocessorCount, dev) != hipSuccess) { grid = -1; return; }
        if (hipFuncSetAttribute((const void*)trunk_fwd, hipFuncAttributeMaxDynamicSharedMemorySize, LDS_BYTES) != hipSuccess) { fprintf(stderr, "kernel_launch: hipFuncSetAttribute failed\n"); grid = -1; return; }
        if (hipOccupancyMaxActiveBlocksPerMultiprocessor(&per_cu, (const void*)trunk_fwd, NTHREADS, LDS_BYTES) != hipSuccess || per_cu < 1)
            fprintf(stderr, "kernel_launch: note: occupancy query reports %d workgroups per CU\n", per_cu);
        (void)hipGetLastError();
        grid = cus & ~7;
    }
    if (grid < 0) return;
    if (hipMemsetAsync((char*)d_ws + WS_CTL, 0, CTL_ZERO_BYTES, stream) != hipSuccess) { fprintf(stderr, "kernel_launch: memset failed\n"); return; }
    Args a{};
    for (int i = 0; i < 15; ++i) a.in[i] = (const float*)d_in[i];
    a.out = (float*)d_out; a.ws = (unsigned char*)d_ws; a.pad = 0;
#if MK_N_LAUNCHES == 1
    a.ph_lo = 0; a.ph_hi = N_PHASES; a.li = 0;
    hipLaunchKernelGGL(trunk_fwd, dim3(grid), dim3(NTHREADS), LDS_BYTES, stream, a);
#else
    for (int p = 0; p < N_PHASES; ++p) { a.ph_lo = p; a.ph_hi = p + 1; a.li = 0; hipLaunchKernelGGL(trunk_fwd, dim3(grid), dim3(NTHREADS), LDS_BYTES, stream, a); }
#endif
    const hipError_t le = hipPeekAtLastError();
    if (le != hipSuccess) fprintf(stderr, "kernel_launch: launch failed: %s\n", hipGetErrorName(le));
}
```
